# Optimizing an MI355X kernel written in HIP

```python
import math
import jax
import jax.numpy as jnp
from jax import lax
import numpy as np

D_MODEL = 1024
BATCH = 4
SEQ = 4096
DEPTH = 2

N_EVEN = (DEPTH + 1) // 2
N_ODD = DEPTH // 2
MIX_WIDTH = D_MODEL
D_FF = 4 * D_MODEL
DEEPNORM_ALPHA = (2.0 * DEPTH) ** 0.25
DEEPNORM_BETA = (8.0 * DEPTH) ** -0.25
LN_EPS = 1e-5
RMS_EPS = 1e-6

HY_DIM = MIX_WIDTH // 2
HY_ORDER = 2
HY_SHORT = 3
HY_EMB = 33
HY_BANDS = (HY_EMB - 1) // 2
HY_FILT_HID = 64
HY_DECAY_TARGET = 1e-2
HY_FAST_DECAY_PCT = 0.3
HY_SLOW_DECAY_PCT = 1.5

GDN_HEADS = 4
GDN_DK = 128
GDN_DV = (MIX_WIDTH - HY_DIM) // GDN_HEADS
GDN_CONV = 5
GDN_CHUNK = 64

HG_HEADS = 4
HG_DK = 128
HG_DV = 128
HG_CHUNK = 64

RW_HEADS = 8
RW_HD = 64
RW_DIM = RW_HEADS * RW_HD
RW_W_LORA = 64
RW_A_LORA = 64
RW_G_LORA = 128
RW_GN_EPS = 64e-5

EVEN_SPLITS = (3 * HY_DIM, GDN_HEADS * GDN_DK, GDN_HEADS * GDN_DK, GDN_HEADS * GDN_DV,
               GDN_HEADS * GDN_DV, 2 * GDN_HEADS, GDN_HEADS)
EVEN_IN = sum(EVEN_SPLITS)
RW_SPLITS = (RW_DIM, RW_DIM, RW_DIM, RW_W_LORA, RW_A_LORA, RW_G_LORA)
RW_IN = sum(RW_SPLITS)
ODD_SPLITS = (HG_HEADS * HG_DK, 2 * HG_HEADS * HG_DK, HG_HEADS * HG_DV, HG_HEADS * HG_DV, RW_IN)
ODD_IN = sum(ODD_SPLITS)

kernel_name = 'hybrid_bidir_hyena_gdn_hgrn2_rwkv7'


def split_cols(y, sizes):
    return jnp.split(y, [int(s) for s in np.cumsum(sizes)[:-1]], axis=-1)


def layer_norm(x, g, b):
    xf = x.astype(jnp.float32)
    xc = xf - jnp.mean(xf, -1, keepdims=True)
    var = jnp.mean(xc * xc, -1, keepdims=True)
    return (xc * lax.rsqrt(var + LN_EPS) * g + b).astype(x.dtype)


def rms_norm(x, g):
    return x * lax.rsqrt(jnp.mean(x * x, -1, keepdims=True) + RMS_EPS) * g


def l2_normalize(x):
    return x * lax.rsqrt(jnp.sum(x * x, -1, keepdims=True) + 1e-6)


def centred_dwconv(u, w):
    width = w.shape[0]
    return lax.conv_general_dilated(u, w[:, None, :].astype(u.dtype), (1,), [(width // 2, width // 2)],
                                    dimension_numbers=('NWC', 'WIO', 'NWC'),
                                    feature_group_count=u.shape[-1])


def to_chunks(a, chunk):
    z, b, t, h = a.shape[:4]
    a = a.reshape((z, b, t // chunk, chunk, h) + a.shape[4:])
    return jnp.swapaxes(a, 3, 4)


def from_chunks(a):
    a = jnp.swapaxes(a, 3, 4)
    z, b, n, c, h = a.shape[:5]
    return a.reshape((z, b, n * c, h) + a.shape[5:])


def both_directions(a):
    return jnp.stack([a, jnp.flip(a, 1)], 0)


def merge_directions(o):
    return o[0] + jnp.flip(o[1], 1)


def hyena_filters(seq_len, w1, b1, w2, b2, w3, b3, w4, freq):
    pos = jnp.arange(seq_len, dtype=jnp.float32)[:, None]
    t = pos / max(seq_len - 1, 1)
    bands = jnp.linspace(1e-4, HY_BANDS - 1, HY_BANDS, dtype=jnp.float32)[None, :]
    ang = bands * (2.0 * math.pi / seq_len) * pos
    z = jnp.concatenate([t, jnp.cos(ang), -jnp.sin(ang)], -1)
    h = jnp.sin(freq * (z @ w1 + b1))
    h = jnp.sin(freq * (h @ w2 + b2))
    h = jnp.sin(freq * (h @ w3 + b3))
    h = (h @ w4).reshape(seq_len, HY_ORDER, 2, HY_DIM)
    max_decay = math.log(HY_DECAY_TARGET) / HY_FAST_DECAY_PCT
    min_decay = math.log(HY_DECAY_TARGET) / HY_SLOW_DECAY_PCT
    deltas = jnp.abs(jnp.linspace(min_decay, max_decay, HY_DIM, dtype=jnp.float32))
    window = jnp.exp(-t * deltas)
    return h * window[:, None, None, :]


def hyena_long_conv(u, h_fwd, h_bwd, skip):
    seq_len = u.shape[1]
    h_two = jnp.concatenate([h_fwd.at[0].add(h_bwd[0]), jnp.zeros_like(h_fwd[:1]), h_bwd[:0:-1]], axis=0)
    u_f = jnp.fft.rfft(u, n=2 * seq_len, axis=1)
    h_f = jnp.fft.rfft(h_two, n=2 * seq_len, axis=0)
    y = jnp.fft.irfft(u_f * h_f[None], n=2 * seq_len, axis=1)[:, :seq_len]
    return y + u * skip


def hyena_mixer(u, conv_w, conv_b, filt, skip):
    u = centred_dwconv(u, conv_w) + conv_b
    x1, x2, v = jnp.split(u, 3, axis=-1)
    z = v
    for o, gate in enumerate((x1, x2)):
        z = gate * hyena_long_conv(z, filt[:, o, 0], filt[:, o, 1], skip[o])
    return z


def gated_delta_chunked(q, k, v, beta, log_g):
    c = GDN_CHUNK
    q, k, v = (to_chunks(a, c) for a in (q, k, v))
    beta, log_g = (to_chunks(a, c) for a in (beta, log_g))
    dv = v.shape[-1]
    gam = jnp.cumsum(log_g, axis=-1)
    causal = jnp.tril(jnp.ones((c, c), dtype=bool))
    strict = jnp.tril(jnp.ones((c, c), dtype=bool), -1)
    decay = jnp.exp(jnp.where(causal, gam[..., :, None] - gam[..., None, :], -jnp.inf))
    kk = jnp.einsum('zbnhtd,zbnhsd->zbnhts', k, k)
    a_mat = jnp.where(strict, kk * decay * beta[..., :, None], 0.0)
    rhs = jnp.concatenate([v * beta[..., None], k * (beta * jnp.exp(gam))[..., None]], -1)
    sol = lax.linalg.triangular_solve(a_mat + jnp.eye(c, dtype=a_mat.dtype), rhs,
                                      left_side=True, lower=True, unit_diagonal=True)
    u, w = sol[..., :dv], sol[..., dv:]
    attn = jnp.einsum('zbnhtd,zbnhsd->zbnhts', q, k) * decay
    q_dec = q * jnp.exp(gam)[..., None]
    g_last = gam[..., -1]
    k_dec = k * jnp.exp(g_last[..., None] - gam)[..., None]

    def step(state, inp):
        q_c, a_c, u_c, w_c, k_c, g_c = inp
        v_new = u_c - jnp.einsum('zbhcd,zbhde->zbhce', w_c, state)
        out = jnp.einsum('zbhcd,zbhde->zbhce', q_c, state) + jnp.einsum('zbhts,zbhse->zbhte', a_c, v_new)
        state = state * jnp.exp(g_c)[..., None, None] + jnp.einsum('zbhcd,zbhce->zbhde', k_c, v_new)
        return state, out

    xs = tuple(jnp.moveaxis(a, 2, 0) for a in (q_dec, attn, u, w, k_dec, g_last))
    z, b, _, h, _, dk = q.shape
    state0 = jnp.zeros((z, b, h, dk, dv), q.dtype)
    _, out = lax.scan(step, state0, xs)
    return from_chunks(jnp.moveaxis(out, 0, 2))


def gdn_mixer(q, k, v, zgate, a, b, conv_w, a_log, dt_bias, norm_w):
    bsz, seq = q.shape[:2]
    qkv = jax.nn.silu(centred_dwconv(jnp.concatenate([q, k, v], -1), conv_w))
    q, k, v = split_cols(qkv, (GDN_HEADS * GDN_DK, GDN_HEADS * GDN_DK, GDN_HEADS * GDN_DV))
    q = l2_normalize(q.reshape(bsz, seq, GDN_HEADS, GDN_DK)) * GDN_DK ** -0.5
    k = l2_normalize(k.reshape(bsz, seq, GDN_HEADS, GDN_DK))
    v = v.reshape(bsz, seq, GDN_HEADS, GDN_DV)
    beta = jax.nn.sigmoid(b)
    log_g = -jnp.exp(a_log) * jax.nn.softplus(a.reshape(bsz, seq, 2, GDN_HEADS) + dt_bias)
    log_g = jnp.stack([log_g[:, :, 0], jnp.flip(log_g[:, :, 1], 1)], 0)
    o = gated_delta_chunked(both_directions(q), both_directions(k), both_directions(v),
                            both_directions(beta), log_g)
    o = merge_directions(o)
    o = rms_norm(o, norm_w) * jax.nn.silu(zgate.reshape(bsz, seq, GDN_HEADS, GDN_DV))
    return o.reshape(bsz, seq, GDN_HEADS * GDN_DV)


def hgrn2_chunked(q, k, v, log_f):
    c = HG_CHUNK
    q, k, v, log_f = (to_chunks(a, c) for a in (q, k, v, log_f))
    gam = jnp.cumsum(log_f, axis=-2)
    causal = jnp.tril(jnp.ones((c, c), dtype=bool))[..., None]

    def step(state, inp):
        q_c, k_c, v_c, g_c = inp
        inter = jnp.einsum('zbhcd,zbhde->zbhce', q_c * jnp.exp(g_c), state)
        dec = jnp.exp(jnp.where(causal, g_c[..., :, None, :] - g_c[..., None, :, :], -jnp.inf))
        attn = jnp.einsum('zbhtd,zbhsd,zbhtsd->zbhts', q_c, k_c, dec)
        out = inter + jnp.einsum('zbhts,zbhse->zbhte', attn, v_c)
        g_last = g_c[..., -1:, :]
        state = (state * jnp.exp(g_last)[..., 0, :, None]
                 + jnp.einsum('zbhcd,zbhce->zbhde', k_c * jnp.exp(g_last - g_c), v_c))
        return state, out

    xs = tuple(jnp.moveaxis(a, 2, 0) for a in (q, k, v, gam))
    z, b, _, h, _, dk = q.shape
    state0 = jnp.zeros((z, b, h, dk, v.shape[-1]), q.dtype)
    _, out = lax.scan(step, state0, xs)
    return from_chunks(jnp.moveaxis(out, 0, 2))


def hgrn2_mixer(q, f, i, g, lower_bound, norm_w):
    bsz, seq = q.shape[:2]

    def heads(a, d):
        return a.reshape(bsz, seq, HG_HEADS, d)

    q = heads(jax.nn.silu(q), HG_DK)
    fg = lower_bound + (1.0 - lower_bound) * jax.nn.sigmoid(f.reshape(bsz, seq, 2, HG_HEADS * HG_DK))
    fg = fg.reshape(bsz, seq, 2, HG_HEADS, HG_DK)
    fz = jnp.stack([fg[:, :, 0], jnp.flip(fg[:, :, 1], 1)], 0)
    o = hgrn2_chunked(both_directions(q), 1.0 - fz, both_directions(heads(i, HG_DV)), jnp.log(fz))
    o = merge_directions(o)
    o = rms_norm(o, norm_w) * jax.nn.silu(heads(g, HG_DV))
    return o.reshape(bsz, seq, HG_HEADS * HG_DV)


def rwkv7_mixer(u, mu, w0, w2, a0, a2, g2, k_k, k_a, r_k, lnx_w, lnx_b):
    bsz, seq = u.shape[:2]
    prev = jnp.pad(u, ((0, 0), (1, 0), (0, 0)))[:, :-1]
    nxt = jnp.pad(u, ((0, 0), (0, 1), (0, 0)))[:, 1:]
    u = u + mu[0] * (prev - u) + mu[1] * (nxt - u)
    r, k, v, w_lo, a_lo, g_lo = split_cols(u, RW_SPLITS)
    w_raw = w0[:, None, None, :] + jnp.einsum('btr,zrc->zbtc', jnp.tanh(w_lo), w2)
    log_w = -jnp.exp(-jax.nn.softplus(-w_raw) - 0.5)
    a = jax.nn.sigmoid(a0 + a_lo @ a2)
    g = jax.nn.sigmoid(g_lo) @ g2

    def heads(t):
        return t.reshape(t.shape[:-1] + (RW_HEADS, RW_HD))

    kk = l2_normalize(heads(k * k_k))
    k = k * (1.0 + (a - 1.0) * k_a)
    r, k, v, a = heads(r), heads(k), heads(v), heads(a)
    decay = jnp.exp(heads(log_w))
    decay = jnp.stack([decay[0], jnp.flip(decay[1], 1)], 0)
    xs = (both_directions(r), decay, both_directions(k), both_directions(v),
          both_directions(kk), both_directions(kk * a))
    xs = tuple(jnp.moveaxis(t, 2, 0) for t in xs)

    def step(state, inp):
        r_t, w_t, k_t, v_t, kk_t, kka_t = inp
        sa = jnp.einsum('zbhvk,zbhk->zbhv', state, kk_t)
        state = (state * w_t[..., None, :] - sa[..., :, None] * kka_t[..., None, :]
                 + v_t[..., :, None] * k_t[..., None, :])
        return state, jnp.einsum('zbhvk,zbhk->zbhv', state, r_t)

    state0 = jnp.zeros((2, bsz, RW_HEADS, RW_HD, RW_HD), r.dtype)
    _, y = lax.scan(step, state0, xs)
    y = merge_directions(jnp.moveaxis(y, 0, 2))
    yc = y - jnp.mean(y, -1, keepdims=True)
    y = yc * lax.rsqrt(jnp.mean(yc * yc, -1, keepdims=True) + RW_GN_EPS)
    y = y.reshape(bsz, seq, RW_DIM) * lnx_w + lnx_b
    bonus = jnp.sum(r * k * r_k, -1, keepdims=True) * v
    return (y + bonus.reshape(bsz, seq, RW_DIM)) * g


def even_layer_mixer(x, w_in, hy_conv_w, hy_conv_b, f_w1, f_b1, f_w2, f_b2, f_w3, f_b3, f_w4, f_freq,
                     hy_skip, gdn_conv_w, gdn_a_log, gdn_dt_bias, gdn_norm_w, w_out):
    proj = (x @ w_in).astype(jnp.float32)
    hy_in, q, k, v, zg, a, b = split_cols(proj, EVEN_SPLITS)
    filt = hyena_filters(x.shape[1], f_w1, f_b1, f_w2, f_b2, f_w3, f_b3, f_w4, f_freq)
    y_a = hyena_mixer(hy_in, hy_conv_w, hy_conv_b, filt, hy_skip)
    y_b = gdn_mixer(q, k, v, zg, a, b, gdn_conv_w, gdn_a_log, gdn_dt_bias, gdn_norm_w)
    return jnp.concatenate([y_a, y_b], -1).astype(x.dtype) @ w_out


def odd_layer_mixer(x, w_in, lower_bound, hg_norm_w, rw_mu, rw_w0, rw_w2, rw_a0, rw_a2, rw_g2,
                    rw_k_k, rw_k_a, rw_r_k, rw_lnx_w, rw_lnx_b, w_out):
    proj = (x @ w_in).astype(jnp.float32)
    q, f, i, g, rw_in = split_cols(proj, ODD_SPLITS)
    y_c = hgrn2_mixer(q, f, i, g, lower_bound, hg_norm_w)
    y_d = rwkv7_mixer(rw_in, rw_mu, rw_w0, rw_w2, rw_a0, rw_a2, rw_g2, rw_k_k, rw_k_a, rw_r_k,
                      rw_lnx_w, rw_lnx_b)
    return jnp.concatenate([y_c, y_d], -1).astype(x.dtype) @ w_out


def sq_relu_mlp(x, w1, w2):
    return jnp.square(jax.nn.relu(x @ w1)) @ w2


def setup_inputs(seed: int = 0) -> dict:
    key = jax.random.key(seed)
    keys = list(jax.random.split(key, 48))

    def nrm(shape, scale):
        return jax.random.normal(keys.pop(), shape, jnp.float32) * scale

    def uni(shape, lo, hi):
        return jax.random.uniform(keys.pop(), shape, jnp.float32, lo, hi)

    beta = DEEPNORM_BETA
    ev_scale = jnp.concatenate([
        jnp.ones((2 * HY_DIM,)), jnp.full((HY_DIM,), beta),
        jnp.ones((2 * GDN_HEADS * GDN_DK,)), jnp.full((GDN_HEADS * GDN_DV,), beta),
        jnp.ones((GDN_HEADS * GDN_DV + 3 * GDN_HEADS,))])
    od_scale = jnp.concatenate([
        jnp.ones((3 * HG_HEADS * HG_DK,)), jnp.full((HG_HEADS * HG_DV,), beta),
        jnp.ones((HG_HEADS * HG_DV + 2 * RW_DIM,)), jnp.full((RW_DIM,), beta),
        jnp.ones((RW_W_LORA + RW_A_LORA + RW_G_LORA,))])
    dt = jnp.exp(uni((N_EVEN, 2, GDN_HEADS), math.log(1e-3), math.log(1e-1)))
    return {
        'x': nrm((BATCH, SEQ, D_MODEL), 1.0),
        'ev_w_in': nrm((N_EVEN, D_MODEL, EVEN_IN), D_MODEL ** -0.5) * ev_scale,
        'hy_conv_w': nrm((N_EVEN, HY_SHORT, 3 * HY_DIM), HY_SHORT ** -0.5),
        'hy_conv_b': nrm((N_EVEN, 3 * HY_DIM), 0.02),
        'hy_filt_w1': nrm((N_EVEN, HY_EMB, HY_FILT_HID), HY_EMB ** -0.5),
        'hy_filt_b1': nrm((N_EVEN, HY_FILT_HID), 0.1),
        'hy_filt_w2': nrm((N_EVEN, HY_FILT_HID, HY_FILT_HID), HY_FILT_HID ** -0.5),
        'hy_filt_b2': nrm((N_EVEN, HY_FILT_HID), 0.1),
        'hy_filt_w3': nrm((N_EVEN, HY_FILT_HID, HY_FILT_HID), HY_FILT_HID ** -0.5),
        'hy_filt_b3': nrm((N_EVEN, HY_FILT_HID), 0.1),
        'hy_filt_w4': nrm((N_EVEN, HY_FILT_HID, HY_ORDER * 2 * HY_DIM), 0.1 * HY_FILT_HID ** -0.5),
        'hy_filt_freq': 1.0 + nrm((N_EVEN, HY_FILT_HID), 0.1),
        'hy_skip': nrm((N_EVEN, HY_ORDER, HY_DIM), 0.5),
        'gdn_conv_w': nrm((N_EVEN, GDN_CONV, 2 * GDN_HEADS * GDN_DK + GDN_HEADS * GDN_DV), GDN_CONV ** -0.5),
        'gdn_a_log': jnp.log(uni((N_EVEN, 2, GDN_HEADS), 1.0, 16.0)),
        'gdn_dt_bias': dt + jnp.log(-jnp.expm1(-dt)),
        'gdn_norm_w': 1.0 + nrm((N_EVEN, GDN_DV), 0.1),
        'ev_w_out': nrm((N_EVEN, MIX_WIDTH, D_MODEL), MIX_WIDTH ** -0.5 * beta),
        'od_w_in': nrm((N_ODD, D_MODEL, ODD_IN), D_MODEL ** -0.5) * od_scale,
        'hg_lower': nrm((DEPTH, HG_HEADS * HG_DK), 1.0),
        'hg_norm_w': 1.0 + nrm((N_ODD, HG_DV), 0.1),
        'rw_mu': uni((N_ODD, 2, RW_IN), 0.0, 0.5),
        'rw_w0': uni((N_ODD, 2, RW_DIM), -6.0, -1.0),
        'rw_w2': nrm((N_ODD, 2, RW_W_LORA, RW_DIM), 0.1 * RW_W_LORA ** -0.5),
        'rw_a0': nrm((N_ODD, RW_DIM), 0.1),
        'rw_a2': nrm((N_ODD, RW_A_LORA, RW_DIM), RW_A_LORA ** -0.5),
        'rw_g2': nrm((N_ODD, RW_G_LORA, RW_DIM), RW_G_LORA ** -0.5),
        'rw_k_k': 0.85 + nrm((N_ODD, RW_DIM), 0.05),
        'rw_k_a': 1.0 + nrm((N_ODD, RW_DIM), 0.05),
        'rw_r_k': nrm((N_ODD, RW_HEADS, RW_HD), 0.1),
        'rw_lnx_w': 1.0 + nrm((N_ODD, RW_DIM), 0.1),
        'rw_lnx_b': nrm((N_ODD, RW_DIM), 0.05),
        'od_w_out': nrm((N_ODD, MIX_WIDTH, D_MODEL), MIX_WIDTH ** -0.5 * beta),
        'ln_g': 1.0 + nrm((DEPTH, 2, D_MODEL), 0.05),
        'ln_b': nrm((DEPTH, 2, D_MODEL), 0.02),
        'mlp_w1': nrm((DEPTH, D_MODEL, D_FF), D_MODEL ** -0.5 * beta),
        'mlp_w2': nrm((DEPTH, D_FF, D_MODEL), D_FF ** -0.5 * beta),
    }


def reference(x, ev_w_in, hy_conv_w, hy_conv_b, hy_filt_w1, hy_filt_b1, hy_filt_w2, hy_filt_b2,
              hy_filt_w3, hy_filt_b3, hy_filt_w4, hy_filt_freq, hy_skip, gdn_conv_w, gdn_a_log,
              gdn_dt_bias, gdn_norm_w, ev_w_out, od_w_in, hg_lower, hg_norm_w, rw_mu, rw_w0, rw_w2,
              rw_a0, rw_a2, rw_g2, rw_k_k, rw_k_a, rw_r_k, rw_lnx_w, rw_lnx_b, od_w_out, ln_g, ln_b,
              mlp_w1, mlp_w2):
    lb_all = jnp.cumsum(jax.nn.softmax(hg_lower.astype(jnp.float32), axis=0), axis=0)
    lb_all = lb_all - lb_all[0]
    for layer in range(DEPTH):
        idx = layer // 2
        if layer % 2 == 0:
            mix = even_layer_mixer(x, ev_w_in[idx], hy_conv_w[idx], hy_conv_b[idx], hy_filt_w1[idx],
                                   hy_filt_b1[idx], hy_filt_w2[idx], hy_filt_b2[idx], hy_filt_w3[idx],
                                   hy_filt_b3[idx], hy_filt_w4[idx], hy_filt_freq[idx], hy_skip[idx],
                                   gdn_conv_w[idx], gdn_a_log[idx], gdn_dt_bias[idx], gdn_norm_w[idx],
                                   ev_w_out[idx])
        else:
            mix = odd_layer_mixer(x, od_w_in[idx], lb_all[layer], hg_norm_w[idx], rw_mu[idx], rw_w0[idx],
                                  rw_w2[idx], rw_a0[idx], rw_a2[idx], rw_g2[idx], rw_k_k[idx], rw_k_a[idx],
                                  rw_r_k[idx], rw_lnx_w[idx], rw_lnx_b[idx], od_w_out[idx])
        x = layer_norm(DEEPNORM_ALPHA * x + mix, ln_g[layer, 0], ln_b[layer, 0])
        x = layer_norm(DEEPNORM_ALPHA * x + sq_relu_mlp(x, mlp_w1[layer], mlp_w2[layer]),
                       ln_g[layer, 1], ln_b[layer, 1])
    return x
```

```cpp
#include <hip/hip_runtime.h>
#include <hip/hip_cooperative_groups.h>
#include <cstdio>
namespace cg = cooperative_groups;
namespace pg8 {
#define PG8_LAS __attribute__((address_space(3)))
typedef unsigned short bf16_t;
typedef short bf16x8 __attribute__((ext_vector_type(8)));
typedef float f32x4 __attribute__((ext_vector_type(4)));
typedef unsigned u32x4 __attribute__((ext_vector_type(4)));
constexpr int BM = 256, BK = 64, HALF = 128, HTB = HALF * BK * 2  , STAGE_BYTES = 8 * HTB, NXCD = 8, WGM = 8;

__host__ __device__ __forceinline__ int lds_byte(int r, int c) { const int st = (r >> 4) * 2 + (c >> 5), rr = r & 15, cc = c & 31, ob = rr * 64 + cc * 2; return st * 1024 + (ob ^ (((ob >> 9) & 1) << 5)); }
__host__ __device__ __forceinline__ void stage_rc(int b, int& R, int& C) { const int st = b / 1024, sb = b % 1024, swz = sb ^ (((sb >> 9) & 1) << 5); R = (st >> 1) * 16 + swz / 64; C = (st & 1) * 32 + (swz % 64) / 2; }
__host__ __device__ __forceinline__ int perm32(int rho) { const int n = rho >> 4, i = rho & 15; return 8 * (i >> 2) + 4 * n + (i & 3); }

struct Unit { int pm, pn; };
struct Gemm { const bf16_t* A; const bf16_t* Bt; int M, N, K; };

struct StaticOrder {
    int nM, nN, nwg, G, c;
    __host__ __device__ void init(int M, int N, int G_, int c_) { nM = M / BM; nN = N / BM; nwg = nM * nN; G = G_; c = c_; }
    __host__ __device__ bool next(int i, Unit& u) const {
        const long L = (long)i * G + c; if (L >= nwg) return false;
        int wgid = (int)L; { const int q = nwg / NXCD, r = nwg % NXCD, xcd = wgid % NXCD, off = wgid / NXCD; wgid = (xcd < r ? xcd * (q + 1) : r * (q + 1) + (xcd - r) * q) + off; }
        const int nig = WGM * nN, gid = wgid / nig, fm = gid * WGM, gsz = (nM - fm) < WGM ? (nM - fm) : WGM;
        u.pm = fm + ((wgid % nig) % gsz); u.pn = (wgid % nig) / gsz; return true;
    }
    __device__ __forceinline__ void a_ready(const Unit&) const {}
    __device__ __forceinline__ void done(const Unit&) const {}
};
__device__ __forceinline__ unsigned cvt_pk_bf16(float lo, float hi) { unsigned r; asm volatile("v_cvt_pk_bf16_f32 %0, %1, %2" : "=v"(r) : "v"(lo), "v"(hi)); return r; }
template <class Epi, class Sched>
__device__ __forceinline__ void gemm_phase(PG8_LAS unsigned char* lds, const Gemm g, const Sched& S, const Epi& E) {
    const int tid = threadIdx.x, wid = __builtin_amdgcn_readfirstlane(tid >> 6), lane = tid & 63, wr = wid >> 2, wc = wid & 3, fr = lane & 15, fq = lane >> 4;
    const int K = g.K, nt = K / BK;
    unsigned voffA[2], voffB[2];
#pragma unroll
    for (int i = 0; i < 2; ++i) { int R, C; stage_rc(tid * 16 + i * 8192, R, C); const int Rb = Epi::PERM ? ((R & ~31) + perm32(R & 31)) : R;
        voffA[i] = (unsigned)(R * K + C) * 2u; voffB[i] = (unsigned)(Rb * K + C) * 2u; }
    const size_t kstep = (size_t)(BK * 2);
    const size_t hstep = (size_t)HALF * K * 2;
    const size_t tstep = 2 * hstep;
    const unsigned ldsw = (unsigned)wid * 1024u;
    const int aoff = lds_byte(wr * 64 + fr, fq * 8), boff = lds_byte(wc * 32 + fr, fq * 8);
#define PG8_SA(b, h) (((b) * 2 + (h)) * HTB)
#define PG8_SB(b, h) ((4 + (b) * 2 + (h)) * HTB)
#define PG8_STAGE(bufoff, gbase, voff) do { _Pragma("unroll") for (int _i = 0; _i < 2; ++_i) \
        __builtin_amdgcn_global_load_lds((const unsigned*)((const char*)(gbase) + (voff)[_i]), (PG8_LAS unsigned*)(lds + (bufoff) + ldsw + _i * 8192), 16, 0, 0); } while (0)
#define PG8_LDA(dst, b, h) do { _Pragma("unroll") for (int m = 0; m < 4; ++m) _Pragma("unroll") for (int k = 0; k < 2; ++k) dst[m][k] = *(const PG8_LAS bf16x8*)(lds + PG8_SA(b, h) + aoff + m * 2048 + k * 1024); } while (0)
#define PG8_LDB(dst, b, h) do { _Pragma("unroll") for (int n = 0; n < 2; ++n) _Pragma("unroll") for (int k = 0; k < 2; ++k) dst[n][k] = *(const PG8_LAS bf16x8*)(lds + PG8_SB(b, h) + boff + n * 2048 + k * 1024); } while (0)
#define PG8_MMA(ai, bj, At, Bt) do { __builtin_amdgcn_s_setprio(1); _Pragma("unroll") for (int m = 0; m < 4; ++m) _Pragma("unroll") for (int n = 0; n < 2; ++n) _Pragma("unroll") for (int k = 0; k < 2; ++k) \
        acc[ai][bj][m][n] = __builtin_amdgcn_mfma_f32_16x16x32_bf16(Bt[n][k], At[m][k], acc[ai][bj][m][n], 0, 0, 0); __builtin_amdgcn_s_setprio(0); } while (0)
#define PG8_WAIT_V(n) asm volatile("s_waitcnt vmcnt(" #n ")" ::: "memory")
#define PG8_WAIT_L(n) asm volatile("s_waitcnt lgkmcnt(" #n ")" ::: "memory")
#define PG8_BAR __builtin_amdgcn_s_barrier()
#define PG8_SCHED __builtin_amdgcn_sched_barrier(0)
    Unit cur, nxt; int ui = 0;
    if (!S.next(0, cur)) return;
    f32x4 acc[2][2][4][2];
#pragma unroll
    for (int a = 0; a < 2; ++a)
#pragma unroll
        for (int b = 0; b < 2; ++b)
#pragma unroll
            for (int m = 0; m < 4; ++m)
#pragma unroll
                for (int n = 0; n < 2; ++n) acc[a][b][m][n] = (f32x4){0.f, 0.f, 0.f, 0.f};
    bf16x8 At[4][2], B0[2][2], B1[2][2];
    const char* cA = (const char*)g.A + (size_t)cur.pm * tstep; const char* cB = (const char*)g.Bt + (size_t)cur.pn * tstep;
    S.a_ready(cur);
    PG8_STAGE(PG8_SB(0, 0), cB, voffB); PG8_STAGE(PG8_SA(0, 0), cA, voffA); PG8_STAGE(PG8_SB(0, 1), cB + hstep, voffB); PG8_STAGE(PG8_SA(0, 1), cA + hstep, voffA);
    if (wr == 1) PG8_BAR;
    PG8_WAIT_V(4); PG8_BAR;
    PG8_STAGE(PG8_SB(1, 0), cB + kstep, voffB); PG8_STAGE(PG8_SA(1, 0), cA + kstep, voffA); PG8_STAGE(PG8_SB(1, 1), cB + hstep + kstep, voffB);
    PG8_WAIT_V(6); PG8_BAR;
    for (;;) {
        const bool has_next = S.next(ui + 1, nxt);
        const char* nA = has_next ? (const char*)g.A + (size_t)nxt.pm * tstep : cA; const char* nB = has_next ? (const char*)g.Bt + (size_t)nxt.pn * tstep : cB;
        for (int t = 0; t < nt; t += 2) {
            const bool last = (t == nt - 2);
            const char* a1 = cA + (size_t)(t + 1) * kstep;
            const char* a2 = last ? nA : cA + (size_t)(t + 2) * kstep; const char* b2 = last ? nB : cB + (size_t)(t + 2) * kstep;
            const char* a3 = a2 + kstep; const char* b3 = b2 + kstep;
            if (last && has_next) S.a_ready(nxt);
            PG8_LDB(B0, 0, 0); PG8_SCHED; PG8_LDA(At, 0, 0); PG8_STAGE(PG8_SA(1, 1), a1 + hstep, voffA);
            PG8_WAIT_L(8); PG8_BAR; PG8_WAIT_L(0); PG8_MMA(0, 0, At, B0); PG8_BAR; PG8_SCHED;
            PG8_LDB(B1, 0, 1); PG8_STAGE(PG8_SB(0, 0), b2, voffB);
            PG8_BAR; PG8_WAIT_L(0); PG8_MMA(0, 1, At, B1); PG8_BAR;
            PG8_LDA(At, 0, 1); PG8_STAGE(PG8_SA(0, 0), a2, voffA);
            PG8_BAR; PG8_WAIT_L(0); PG8_MMA(1, 0, At, B0); PG8_BAR; PG8_SCHED;
            PG8_STAGE(PG8_SB(0, 1), b2 + hstep, voffB);
            PG8_WAIT_V(6); PG8_BAR; PG8_MMA(1, 1, At, B1); PG8_BAR;
            PG8_LDB(B0, 1, 0); PG8_SCHED; PG8_LDA(At, 1, 0); PG8_STAGE(PG8_SA(0, 1), a2 + hstep, voffA);
            PG8_WAIT_L(8); PG8_BAR; PG8_WAIT_L(0); PG8_MMA(0, 0, At, B0); PG8_BAR; PG8_SCHED;
            PG8_LDB(B1, 1, 1); PG8_STAGE(PG8_SB(1, 0), b3, voffB);
            PG8_BAR; PG8_WAIT_L(0); PG8_MMA(0, 1, At, B1); PG8_BAR;
            PG8_LDA(At, 1, 1); PG8_STAGE(PG8_SA(1, 0), a3, voffA);
            PG8_BAR; PG8_WAIT_L(0); PG8_MMA(1, 0, At, B0); PG8_BAR; PG8_SCHED;
            PG8_STAGE(PG8_SB(1, 1), b3 + hstep, voffB);
            PG8_WAIT_V(6); PG8_BAR; PG8_MMA(1, 1, At, B1); PG8_BAR;
        }
        if constexpr (!Epi::AFTER_DRAIN) { E(acc, cur, wr, wc, fr, fq); S.done(cur); }
        if (!has_next) break;
#pragma unroll
        for (int a = 0; a < 2; ++a)
#pragma unroll
            for (int b = 0; b < 2; ++b)
#pragma unroll
                for (int m = 0; m < 4; ++m)
#pragma unroll
                    for (int n = 0; n < 2; ++n) acc[a][b][m][n] = (f32x4){0.f, 0.f, 0.f, 0.f};
        cur = nxt; cA = nA; cB = nB; ++ui;
    }
    PG8_WAIT_V(0);
    if (wr == 0) PG8_BAR;
    PG8_BAR;
    if constexpr (Epi::AFTER_DRAIN) { E.fused(acc, cur, wr, wc, fr, fq, lds, wid, lane); S.done(cur); }
#undef PG8_SA
#undef PG8_SB
#undef PG8_STAGE
#undef PG8_LDA
#undef PG8_LDB
#undef PG8_MMA
#undef PG8_WAIT_V
#undef PG8_WAIT_L
#undef PG8_BAR
#undef PG8_SCHED
}
}
#define XB_TMO      128
#define XB_XCNT(j)  (256  + 64 * (j))
#define XB_XSUB(j)  (1280 + 64 * (j))
#define XB_XGEN(j)  (2304 + 64 * (j))
#define XB_TOP      3328
#define XB_TOPGEN   3392
#define XCD_BAR_WORDS 3456
#define XB_SPIN_CAP (1u << 18)
#define LAS __attribute__((address_space(3)))

__device__ __forceinline__ unsigned xb_ld(unsigned* p)              { return __hip_atomic_load(p, __ATOMIC_RELAXED, __HIP_MEMORY_SCOPE_AGENT); }
__device__ __forceinline__ unsigned xb_add(unsigned* p, unsigned v) { return __hip_atomic_fetch_add(p, v, __ATOMIC_RELAXED, __HIP_MEMORY_SCOPE_AGENT); }
__device__ __forceinline__ unsigned xb_xcc_id() { return (unsigned)__builtin_amdgcn_s_getreg((3 << 11) | 20) & 0xFu; }
#define XB_SPIN(cond, bar) do { unsigned _sp = 0; while (cond) { __builtin_amdgcn_s_sleep(1); \
    if ((++_sp & 255u) == 0u) { if (xb_ld(&(bar)[XB_TMO])) break; if (_sp > XB_SPIN_CAP) { atomicAdd(&(bar)[XB_TMO], 1u); break; } } } } while (0)

struct XcdBarrier {
    unsigned* bar; unsigned x;
    volatile LAS unsigned* st;
};

__device__ __forceinline__ XcdBarrier xcd_barrier_post(unsigned* bar, volatile LAS unsigned* st) {
    XcdBarrier b; b.bar = bar; b.x = xb_xcc_id(); b.st = st;
    if (threadIdx.x == 0) (void)xb_add(&bar[XB_XCNT(b.x)], 1u);
    return b;
}
__device__ __forceinline__ void xcd_barrier_complete(unsigned* bar, unsigned x, unsigned& nloc, unsigned& nx) {
    const unsigned G = gridDim.x * gridDim.y * gridDim.z;
    unsigned sum, cnt, mine, sp = 0u;
    for (;;) {
        sum = 0u; cnt = 0u; mine = 0u;
#pragma unroll
        for (unsigned j = 0; j < 16; ++j) { const unsigned c = xb_ld(&bar[XB_XCNT(j)]); sum += c; cnt += (c > 0u) ? 1u : 0u; mine = (j == x) ? c : mine; }
        if (sum == G) break;
        __builtin_amdgcn_s_sleep(1);
        if ((++sp & 255u) == 0u) { if (xb_ld(&bar[XB_TMO])) break; if (sp > XB_SPIN_CAP) { atomicAdd(&bar[XB_TMO], 1u); break; } }
    }
    nloc = mine > 0u ? mine : 1u; nx = cnt > 0u ? cnt : 1u;
}

__device__ __forceinline__ void xcd_barrier(const XcdBarrier& b) {
    asm volatile("s_waitcnt vmcnt(0)" ::: "memory");
    __syncthreads();
    if (threadIdx.x == 0) {
        unsigned* bar = b.bar;
        __builtin_amdgcn_s_waitcnt(0);
        unsigned nloc = b.st[0], nx = b.st[1];
        if (nloc == 0u) { xcd_barrier_complete(bar, b.x, nloc, nx); b.st[0] = nloc; b.st[1] = nx; }
        const unsigned old = xb_add(&bar[XB_XSUB(b.x)], 1u);
        const unsigned gen = old / nloc;
        if (old + 1u == (gen + 1u) * nloc) {
            __builtin_amdgcn_fence(__ATOMIC_RELEASE, "agent");
            asm volatile("s_waitcnt vmcnt(0)" ::: "memory");
            const unsigned og = xb_add(&bar[XB_TOP], 1u);
            const unsigned tg = og / nx;
            if (og + 1u == (tg + 1u) * nx) xb_add(&bar[XB_TOPGEN], 1u);
            else XB_SPIN(xb_ld(&bar[XB_TOPGEN]) == tg, bar);
            __builtin_amdgcn_fence(__ATOMIC_ACQUIRE, "agent");
            xb_add(&bar[XB_XGEN(b.x)], 1u);
            asm volatile("s_waitcnt vmcnt(0)" ::: "memory");
        } else {
            XB_SPIN(xb_ld(&bar[XB_XGEN(b.x)]) == gen, bar);
            __builtin_amdgcn_fence(__ATOMIC_ACQUIRE, "agent");
            asm volatile("s_waitcnt vmcnt(0)" ::: "memory");
        }
    }
    __syncthreads();
}

using pg8::bf16_t; using pg8::f32x4; using pg8::u32x4; using pg8::cvt_pk_bf16;

constexpr size_t MBy = 1048576;
constexpr size_t OFF_OD_IN = 0, OFF_OD_OUT = OFF_OD_IN + 4352ull * 1024 * 2, OFF_W1_1 = OFF_OD_OUT + 2097152ull, OFF_W2_1 = OFF_W1_1 + 8388608ull;
constexpr size_t OFF_WT0 = OFF_W2_1 + 8388608ull;
constexpr size_t OFF_EV_IN = OFF_WT0, OFF_EV_OUT = OFF_EV_IN + 3840ull * 1024 * 2, OFF_W1_0 = OFF_EV_OUT + 2097152ull, OFF_W2_0 = OFF_W1_0 + 8388608ull;
static_assert(OFF_W2_0 + 8388608ull == 52 * MBy, "weights region");
constexpr size_t OFF_P = 52 * MBy, OFF_XB = 188 * MBy, OFF_MIX = 220 * MBy, OFF_H3 = 252 * MBy, OFF_SC = 253 * MBy;
constexpr size_t OFF_PH = OFF_P, OFF_PG = OFF_P + 48 * MBy, OFF_QKVP = OFF_P + 120 * MBy;
constexpr size_t OFF_AA = OFF_WT0;
constexpr size_t DO_OB = 0, DO_YA = 32 * MBy, DO_HF = 48 * MBy, DO_FG1 = 56 * MBy, DO_DW0 = 32 * MBy, DO_DW1 = 48 * MBy;
constexpr int LDS_BYTES = 131072 + 1024 + 16;
constexpr size_t OFF_BAR = 255 * MBy;
constexpr float ALPHA = 1.41421356237f;

struct Params { const float* in[37]; float* out; unsigned char* ws; };

__device__ __forceinline__ float bflo(unsigned u) { return __uint_as_float(u << 16); }
__device__ __forceinline__ float bfhi(unsigned u) { return __uint_as_float(u & 0xffff0000u); }
__device__ __forceinline__ float bf1(bf16_t b) { return __uint_as_float(((unsigned)b) << 16); }
__device__ __forceinline__ bf16_t f2bf(float f) { return (bf16_t)(cvt_pk_bf16(f, 0.f) & 0xffffu); }
__device__ __forceinline__ float sigm(float x) { return 1.f / (1.f + __expf(-x)); }
__device__ __forceinline__ float silu(float x) { return x / (1.f + __expf(-x)); }
__device__ __forceinline__ float wave_sum(float x) {
#pragma unroll
    for (int o = 32; o >= 1; o >>= 1) x += __shfl_xor(x, o);
    return x; }
#define DPP_ADD_ROR(x, ctl) x += __int_as_float(__builtin_amdgcn_update_dpp(0, __float_as_int(x), ctl, 0xf, 0xf, false))
__device__ __forceinline__ float rowsum16(float x) {
    DPP_ADD_ROR(x, 0x128); DPP_ADD_ROR(x, 0x124); DPP_ADD_ROR(x, 0x122); DPP_ADD_ROR(x, 0x121); return x; }
__device__ __forceinline__ float rowsum8(float x) {
    DPP_ADD_ROR(x, 0x141); DPP_ADD_ROR(x, 0xB1); DPP_ADD_ROR(x, 0x4E); return x; }
typedef float f32x2_t __attribute__((ext_vector_type(2)));
__device__ __forceinline__ f32x2_t fma2(f32x2_t a, f32x2_t b, f32x2_t c) { return __builtin_elementwise_fma(a, b, c); }
__device__ __forceinline__ void unpack8(uint4 r, float* d) {
    *(float4*)d = make_float4(bflo(r.x), bfhi(r.x), bflo(r.y), bfhi(r.y));
    *(float4*)(d + 4) = make_float4(bflo(r.z), bfhi(r.z), bflo(r.w), bfhi(r.w)); }

template <int ACT> struct EpiBf {
    static constexpr bool PERM = true, AFTER_DRAIN = false;
    bf16_t* O; int ldc;
    __device__ __forceinline__ void operator()(const f32x4 (&acc)[2][2][4][2], const pg8::Unit& u, int wr, int wc, int fr, int fq) const {
        const int row0 = u.pm * 256 + wr * 64 + fr, col0 = u.pn * 256 + wc * 32 + 8 * fq;
#pragma unroll
        for (int ai = 0; ai < 2; ++ai)
#pragma unroll
            for (int m = 0; m < 4; ++m) { bf16_t* rowp = O + (size_t)(row0 + ai * 128 + m * 16) * ldc + col0;
#pragma unroll
                for (int bj = 0; bj < 2; ++bj) { f32x4 v0 = acc[ai][bj][m][0], v1 = acc[ai][bj][m][1];
                    if (ACT == 1) {
#pragma unroll
                        for (int j = 0; j < 4; ++j) { float a = fmaxf(v0[j], 0.f), b = fmaxf(v1[j], 0.f); v0[j] = a * a; v1[j] = b * b; } }
                    u32x4 w; w.x = cvt_pk_bf16(v0[0], v0[1]); w.y = cvt_pk_bf16(v0[2], v0[3]); w.z = cvt_pk_bf16(v1[0], v1[1]); w.w = cvt_pk_bf16(v1[2], v1[3]);
                    *(u32x4*)(rowp + bj * 128) = w; } }
    }
};
template <bool RESBF> struct EpiRes {
    static constexpr bool PERM = false, AFTER_DRAIN = false;
    float* C; const void* res;
    __device__ __forceinline__ void operator()(const f32x4 (&acc)[2][2][4][2], const pg8::Unit& u, int wr, int wc, int fr, int fq) const {
        const int row0 = u.pm * 256 + wr * 64 + fr, col0 = u.pn * 256 + wc * 32 + 4 * fq;
#pragma unroll
        for (int ai = 0; ai < 2; ++ai)
#pragma unroll
            for (int m = 0; m < 4; ++m) { const size_t ro = (size_t)(row0 + ai * 128 + m * 16) * 1024 + col0;
#pragma unroll
                for (int bj = 0; bj < 2; ++bj)
#pragma unroll
                    for (int n = 0; n < 2; ++n) { const size_t o = ro + bj * 128 + n * 16; f32x4 r;
                        if (RESBF) { const uint2 w = *(const uint2*)((const bf16_t*)res + o); r = (f32x4){bflo(w.x), bfhi(w.x), bflo(w.y), bfhi(w.y)}; }
                        else r = *(const f32x4*)((const float*)res + o);
                        *(f32x4*)(C + o) = acc[ai][bj][m][n] + r * ALPHA; } }
    }
};
template <class Epi> __device__ __forceinline__ void run_gemm(unsigned char* shm, const bf16_t* A, const bf16_t* Bt, int M, int N, int K, const Epi& E, int c) {
    pg8::Gemm g; g.A = A; g.Bt = Bt; g.M = M; g.N = N; g.K = K;
    pg8::StaticOrder S; S.init(M, N, (int)gridDim.x, c);
    pg8::gemm_phase<Epi, pg8::StaticOrder>((PG8_LAS unsigned char*)shm, g, S, E);
    __syncthreads();
}

__device__ __forceinline__ void transpose_mat(const float* __restrict__ W, int K, int N, int Npad, bf16_t* __restrict__ Wt, float* lds, int tid, int bid, int nb) {
    const int ntk = K >> 6, ntiles = (Npad >> 6) * ntk;
    for (int tile = bid; tile < ntiles; tile += nb) {
        const int tn = tile / ntk, tk = tile - tn * ntk, n0 = tn << 6, k0 = tk << 6;
        { const int c4 = tid & 15, r = tid >> 4;
#pragma unroll
          for (int rr = 0; rr < 2; ++rr) { const int row = r + rr * 32, n = n0 + c4 * 4; float4 v = make_float4(0.f, 0.f, 0.f, 0.f);
              if (n < N) v = *(const float4*)(W + (size_t)(k0 + row) * N + n);
              float* d = lds + row * 65 + c4 * 4; d[0] = v.x; d[1] = v.y; d[2] = v.z; d[3] = v.w; } }
        __syncthreads();
        { const int n = tid >> 3, kc = tid & 7; u32x4 w;
          w.x = cvt_pk_bf16(lds[(kc * 8 + 0) * 65 + n], lds[(kc * 8 + 1) * 65 + n]); w.y = cvt_pk_bf16(lds[(kc * 8 + 2) * 65 + n], lds[(kc * 8 + 3) * 65 + n]);
          w.z = cvt_pk_bf16(lds[(kc * 8 + 4) * 65 + n], lds[(kc * 8 + 5) * 65 + n]); w.w = cvt_pk_bf16(lds[(kc * 8 + 6) * 65 + n], lds[(kc * 8 + 7) * 65 + n]);
          *(u32x4*)(Wt + (size_t)(n0 + n) * K + k0 + kc * 8) = w; }
        __syncthreads();
    }
}
__device__ __forceinline__ void prep_weights_a(const Params& p, float* lds, int tid, int bid, int nb) {
    unsigned char* ws = p.ws;
    __syncthreads();
    transpose_mat(p.in[17], 1024, 1024, 1024, (bf16_t*)(ws + OFF_EV_OUT), lds, tid, bid, nb);
    transpose_mat(p.in[35], 1024, 4096, 4096, (bf16_t*)(ws + OFF_W1_0), lds, tid, bid, nb);
    transpose_mat(p.in[36], 4096, 1024, 1024, (bf16_t*)(ws + OFF_W2_0), lds, tid, bid, nb);
    transpose_mat(p.in[18], 1024, 4352, 4352, (bf16_t*)(ws + OFF_OD_IN), lds, tid, bid, nb);
}
__device__ __forceinline__ void prep_weights_b(const Params& p, float* lds, int tid, int bid, int nb) {
    unsigned char* ws = p.ws;
    __syncthreads();
    transpose_mat(p.in[32], 1024, 1024, 1024, (bf16_t*)(ws + OFF_OD_OUT), lds, tid, bid, nb);
    transpose_mat(p.in[35] + (size_t)1024 * 4096, 1024, 4096, 4096, (bf16_t*)(ws + OFF_W1_1), lds, tid, bid, nb);
    transpose_mat(p.in[36] + (size_t)1024 * 4096, 4096, 1024, 1024, (bf16_t*)(ws + OFF_W2_1), lds, tid, bid, nb);
}
__device__ __forceinline__ void phase_prep(const Params& p, float* lds, int tid, int bid, int nb) {
    unsigned char* ws = p.ws;
    { const float4* x4 = (const float4*)p.in[0]; uint2* xb = (uint2*)(ws + OFF_XB);
#pragma unroll 2
      for (size_t i = (size_t)bid * 512 + tid; i < (size_t)16384 * 256; i += (size_t)nb * 512) { const float4 v = x4[i]; uint2 o; o.x = cvt_pk_bf16(v.x, v.y); o.y = cvt_pk_bf16(v.z, v.w); xb[i] = o; } }
    transpose_mat(p.in[1], 1024, 3596, 3840, (bf16_t*)(ws + OFF_EV_IN), lds, tid, bid, nb);
    { float* zs = lds; float* ha = lds + 8 * 36; float* hb = ha + 512; float* w1s = hb + 512; float* w2s = w1s + 33 * 64; float* w3s = w2s + 4096; float* H3 = (float*)(ws + OFF_H3);
      const float* b1 = p.in[5]; const float* b2 = p.in[7]; const float* b3 = p.in[9]; const float* fr = p.in[11];
      __syncthreads();
      for (int i = tid; i < 33 * 64; i += 512) w1s[i] = p.in[4][i];
      for (int i = tid; i < 4096; i += 512) { w2s[i] = p.in[6][i]; w3s[i] = p.in[8][i]; }
      const int pl = tid >> 6, j = tid & 63; const float fq = fr[j], bb1 = b1[j], bb2 = b2[j], bb3 = b3[j];
      __syncthreads();
      for (int it = bid; it < 512; it += nb) {
          const int pos = it * 8 + pl;
          if (j < 33) { const float pf = (float)pos; float val;
              if (j == 0) val = pf / 4095.f;
              else { const int bi = (j - 1) & 15; const float band = 1e-4f + (float)bi * ((15.f - 1e-4f) / 15.f); const float ang = band * (6.283185307179586f / 4096.f) * pf; val = (j <= 16) ? cosf(ang) : -sinf(ang); }
              zs[pl * 36 + j] = val; }
          __syncthreads();
          float acc = bb1;
#pragma unroll 11
          for (int i = 0; i < 33; ++i) acc += zs[pl * 36 + i] * w1s[i * 64 + j];
          ha[pl * 64 + j] = sinf(fq * acc);
          __syncthreads();
          acc = bb2;
#pragma unroll 16
          for (int i = 0; i < 64; ++i) acc += ha[pl * 64 + i] * w2s[i * 64 + j];
          hb[pl * 64 + j] = sinf(fq * acc);
          __syncthreads();
          acc = bb3;
#pragma unroll 16
          for (int i = 0; i < 64; ++i) acc += hb[pl * 64 + i] * w3s[i * 64 + j];
          H3[pos * 64 + j] = sinf(fq * acc);
          __syncthreads();
      } }
}

__device__ __forceinline__ void phase_gdn_prep(const Params& p, int tid, int bid, int nb) {
    const int wave = tid >> 6, lane = tid & 63;
    const bf16_t* PG = (const bf16_t*)(p.ws + OFF_PG); bf16_t* QK = (bf16_t*)(p.ws + OFF_QKVP); float* SC = (float*)(p.ws + OFF_SC);
    const float* cw = p.in[13];
    for (int it = bid * 8 + wave; it < 4096 * 4; it += nb * 8) {
        const int tk0 = (it >> 2) * 4, h = it & 3, t0 = tk0 & 4095;
        float acc[4][3][2];
#pragma unroll
        for (int o = 0; o < 4; ++o)
#pragma unroll
            for (int s3 = 0; s3 < 3; ++s3) { acc[o][s3][0] = 0.f; acc[o][s3][1] = 0.f; }
        float2 w[5][3];
#pragma unroll
        for (int j = 0; j < 5; ++j)
#pragma unroll
            for (int s3 = 0; s3 < 3; ++s3) w[j][s3] = *(const float2*)(cw + j * 1536 + s3 * 512 + h * 128 + lane * 2);
#pragma unroll
        for (int r = 0; r < 8; ++r) { const int tt = t0 + r - 2;
            if (tt >= 0 && tt < 4096) { const bf16_t* row = PG + (size_t)(tk0 + r - 2) * 2304 + h * 128 + lane * 2;
#pragma unroll
                for (int s3 = 0; s3 < 3; ++s3) { const unsigned u = *(const unsigned*)(row + s3 * 512); const float u0 = bflo(u), u1 = bfhi(u);
#pragma unroll
                    for (int j = 0; j < 5; ++j) { const int o = r - j; if (o >= 0 && o < 4) { acc[o][s3][0] += w[j][s3].x * u0; acc[o][s3][1] += w[j][s3].y * u1; } } } } }
#pragma unroll
        for (int o = 0; o < 4; ++o) { const int tk = tk0 + o;
#pragma unroll
            for (int s3 = 0; s3 < 3; ++s3) { acc[o][s3][0] = silu(acc[o][s3][0]); acc[o][s3][1] = silu(acc[o][s3][1]); }
            float sq = acc[o][0][0] * acc[o][0][0] + acc[o][0][1] * acc[o][0][1], sk = acc[o][1][0] * acc[o][1][0] + acc[o][1][1] * acc[o][1][1];
#pragma unroll
            for (int sh = 32; sh >= 1; sh >>= 1) { sq += __shfl_xor(sq, sh); sk += __shfl_xor(sk, sh); }
            const float rq = rsqrtf(sq + 1e-6f) * 0.08838834764831845f, rk = rsqrtf(sk + 1e-6f);
            bf16_t* op = QK + (size_t)tk * 1536 + h * 128 + lane * 2;
            *(unsigned*)(op) = cvt_pk_bf16(acc[o][0][0] * rq, acc[o][0][1] * rq);
            *(unsigned*)(op + 512) = cvt_pk_bf16(acc[o][1][0] * rk, acc[o][1][1] * rk);
            *(unsigned*)(op + 1024) = cvt_pk_bf16(acc[o][2][0], acc[o][2][1]);
            if (lane < 3) { const bf16_t* row = PG + (size_t)tk * 2304; float val;
                if (lane == 0) val = sigm(bf1(row[2056 + h]));
                else { const int d = lane - 1; const float a = bf1(row[2048 + d * 4 + h]) + p.in[15][d * 4 + h]; const float sp = a > 20.f ? a : log1pf(expf(a)); val = expf(-expf(p.in[14][d * 4 + h]) * sp); }
                SC[((size_t)tk * 4 + h) * 4 + lane] = val; } }
    }
}

__device__ __forceinline__ float2 cmul(float2 a, float2 b) { return make_float2(a.x * b.x - a.y * b.y, a.x * b.y + a.y * b.x); }
__device__ __forceinline__ float2 cadd(float2 a, float2 b) { return make_float2(a.x + b.x, a.y + b.y); }
__device__ __forceinline__ float2 csub(float2 a, float2 b) { return make_float2(a.x - b.x, a.y - b.y); }
template <bool ZP> __device__ __forceinline__ void fft_fwd(float2* D, int tid) {
    for (int S = 4096; S >= 4; S >>= 2) {
        const int Q = S >> 1; const float inv = -0.5f / (float)S; const bool zp = ZP && S == 4096;
#pragma unroll 2
        for (int i = tid; i < 2048; i += 512) { const int k = i & (Q - 1), j = ((i - k) << 2) + k;
            const float2 x0 = D[j], x1 = D[j + Q]; float2 x2 = make_float2(0.f, 0.f), x3 = x2;
            if (!zp) { x2 = D[j + 2 * Q]; x3 = D[j + 3 * Q]; }
            const float rev = (float)k * inv;
            const float2 w1 = make_float2(__builtin_amdgcn_cosf(rev), __builtin_amdgcn_sinf(rev)), w2 = make_float2(w1.x * w1.x - w1.y * w1.y, 2.f * w1.x * w1.y);
            const float2 a0 = cadd(x0, x2), a2 = cmul(csub(x0, x2), w1), a1 = cadd(x1, x3), t = cmul(csub(x1, x3), w1), a3 = make_float2(t.y, -t.x);
            D[j] = cadd(a0, a1); D[j + Q] = cmul(csub(a0, a1), w2); D[j + 2 * Q] = cadd(a2, a3); D[j + 3 * Q] = cmul(csub(a2, a3), w2); }
        __syncthreads();
    }
#pragma unroll 2
    for (int i = tid; i < 4096; i += 512) { const float2 a = D[2 * i], b = D[2 * i + 1]; D[2 * i] = cadd(a, b); D[2 * i + 1] = csub(a, b); }
    __syncthreads();
}
__device__ __forceinline__ void fft_inv(float2* D, int tid) {
#pragma unroll 2
    for (int i = tid; i < 4096; i += 512) { const float2 a = D[2 * i], b = D[2 * i + 1]; D[2 * i] = cadd(a, b); D[2 * i + 1] = csub(a, b); }
    __syncthreads();
    for (int s = 2; s <= 2048; s <<= 2) {
        const float inv = 0.25f / (float)s; const bool last = s == 2048;
#pragma unroll 2
        for (int i = tid; i < 2048; i += 512) { const int k = i & (s - 1), j = ((i - k) << 2) + k;
            const float2 x0 = D[j], x1 = D[j + s], x2 = D[j + 2 * s], x3 = D[j + 3 * s];
            const float rev = (float)k * inv;
            const float2 v = make_float2(__builtin_amdgcn_cosf(rev), __builtin_amdgcn_sinf(rev)), u1 = make_float2(v.x * v.x - v.y * v.y, 2.f * v.x * v.y);
            float2 t = cmul(x1, u1); const float2 a0 = cadd(x0, t), a1 = csub(x0, t); t = cmul(x3, u1); const float2 a2 = cadd(x2, t), a3 = csub(x2, t);
            t = cmul(a2, v); D[j] = cadd(a0, t); if (!last) D[j + 2 * s] = csub(a0, t);
            t = cmul(a3, v); t = make_float2(-t.y, t.x); D[j + s] = cadd(a1, t); if (!last) D[j + 3 * s] = csub(a1, t); }
        __syncthreads();
    }
}
__device__ __forceinline__ float conv3(const bf16_t* row, int t, float w0, float w1, float w2, float bias) {
    const bf16_t* q = row + t;
    const bf16_t a = q[-1], b = q[0], c = q[1];
    const float um = t > 0 ? bf1(a) : 0.f, u0 = bf1(b), up = t < 4095 ? bf1(c) : 0.f;
    return w0 * um + w1 * u0 + w2 * up + bias; }
__device__ __forceinline__ void hyena_channel(const Params& p, int c, int slot, float* lds, int tid) {
    float2* D = (float2*)lds; float* Z = lds + 16384; float* w4s = lds + 32768;
    float2* HfG = (float2*)((unsigned char*)p.out + DO_HF) + (size_t)slot * 8192;
    const bf16_t* PH = (const bf16_t*)(p.ws + OFF_PH); const float* H3 = (const float*)(p.ws + OFF_H3);
    const float* cw = p.in[2]; const float* cb = p.in[3]; const float* w4 = p.in[10]; const float* skp = p.in[12];
    bf16_t* YA = (bf16_t*)((unsigned char*)p.out + DO_YA);
    __syncthreads();
    { const int ch = 1024 + c; const float w0 = cw[ch], w1 = cw[1536 + ch], w2 = cw[3072 + ch], bb = cb[ch]; const bf16_t* row = PH + (size_t)ch * 16384;
#pragma unroll 2
      for (int idx = tid; idx < 16384; idx += 512) { const int t = idx & 4095; Z[idx] = conv3(row + (idx - t), t, w0, w1, w2, bb); } }
    const float delta = fabsf(-3.0701134573253944f + (float)c * ((-15.350567286626972f + 3.0701134573253944f) / 511.f));
    float* FG1 = (float*)((unsigned char*)p.out + DO_FG1) + (size_t)slot * 8192;
    if (tid < 256) w4s[tid] = w4[(tid & 63) * 2048 + (tid >> 6) * 512 + c];
    __syncthreads();
#pragma unroll 1
    for (int hlf = 0; hlf < 2; ++hlf) { float acc[4][4]; const int tb = tid + 2048 * hlf;
#pragma unroll
      for (int i = 0; i < 4; ++i) { acc[i][0] = 0.f; acc[i][1] = 0.f; acc[i][2] = 0.f; acc[i][3] = 0.f; }
#pragma unroll 1
      for (int jj = 0; jj < 64; jj += 4) {
          float4 hv[4];
#pragma unroll
          for (int i = 0; i < 4; ++i) hv[i] = *(const float4*)(H3 + (tb + 512 * i) * 64 + jj);
#pragma unroll
          for (int q = 0; q < 4; ++q) { const float4 wv = *(const float4*)(w4s + q * 64 + jj);
#pragma unroll
              for (int i = 0; i < 4; ++i) acc[i][q] += (hv[i].x * wv.x + hv[i].y * wv.y) + (hv[i].z * wv.z + hv[i].w * wv.w); } }
#pragma unroll
      for (int i = 0; i < 4; ++i) { const int t = tb + 512 * i; const float win = expf(-((float)t / 4095.f) * delta);
          const float hf0 = acc[i][0] * win, hb0 = acc[i][1] * win, hf1 = acc[i][2] * win, hb1 = acc[i][3] * win;
          if (t == 0) { D[0] = make_float2(hf0 + hb0, 0.f); D[4096] = make_float2(0.f, 0.f); FG1[0] = hf1 + hb1; FG1[4096] = 0.f; }
          else { D[t] = make_float2(hf0, 0.f); D[8192 - t] = make_float2(hb0, 0.f); FG1[t] = hf1; FG1[8192 - t] = hb1; } } }
#pragma unroll 1
    for (int o = 0; o < 2; ++o) {
        __syncthreads();
        if (o == 1) {
#pragma unroll 4
            for (int idx = tid; idx < 8192; idx += 512) D[idx] = make_float2(FG1[idx], 0.f); }
        __syncthreads();
        fft_fwd<false>(D, tid);
#pragma unroll 2
        for (int idx = tid; idx < 8192; idx += 512) HfG[idx] = D[idx];
        const float skip = skp[o * 512 + c];
        const int gch = o * 512 + c; const float g0 = cw[gch], g1 = cw[1536 + gch], g2 = cw[3072 + gch], gb = cb[gch];
#pragma unroll 1
        for (int pr = 0; pr < 2; ++pr) {
            __syncthreads();
#pragma unroll 2
            for (int t = tid; t < 4096; t += 512) D[t] = make_float2(Z[(2 * pr) * 4096 + t], Z[(2 * pr + 1) * 4096 + t]);
            __syncthreads();
            fft_fwd<true>(D, tid);
#pragma unroll 2
            for (int idx = tid; idx < 8192; idx += 512) { const float2 a = D[idx], hh = HfG[idx]; D[idx] = make_float2(a.x * hh.x - a.y * hh.y, a.x * hh.y + a.y * hh.x); }
            __syncthreads();
            fft_inv(D, tid);
            const bf16_t* grow = PH + (size_t)gch * 16384 + (2 * pr) * 4096;
#pragma unroll 2
            for (int t = tid; t < 4096; t += 512) { const float2 y = D[t];
                const float ga = conv3(grow, t, g0, g1, g2, gb), gbv = conv3(grow + 4096, t, g0, g1, g2, gb);
                Z[(2 * pr) * 4096 + t] = ga * (y.x * (1.f / 8192.f) + skip * Z[(2 * pr) * 4096 + t]);
                Z[(2 * pr + 1) * 4096 + t] = gbv * (y.y * (1.f / 8192.f) + skip * Z[(2 * pr + 1) * 4096 + t]); }
        }
    }
    __syncthreads();
#pragma unroll 2
    for (int idx = tid; idx < 16384; idx += 512) YA[(size_t)c * 16384 + idx] = f2bf(Z[idx]);
    __syncthreads();
}

__device__ __forceinline__ void phase_post0(const Params& p, float* lds, int tid, int bid, int nb) {
    const int wave = tid >> 6, lane = tid & 63;
    bf16_t* MIX = (bf16_t*)(p.ws + OFF_MIX); const bf16_t* OB = (const bf16_t*)((unsigned char*)p.out + DO_OB); const bf16_t* PG = (const bf16_t*)(p.ws + OFF_PG);
    const float* nw = p.in[16];
    const float n0 = nw[lane * 2], n1 = nw[lane * 2 + 1];
#pragma unroll 4
    for (int it = bid * 8 + wave; it < 16384 * 4; it += nb * 8) {
        const int tk = it >> 2, h = it & 3; const size_t o = (size_t)tk * 1024 + 512 + h * 128 + lane * 2;
        const unsigned uf = *(const unsigned*)(MIX + o), ub = *(const unsigned*)(OB + o), uz = *(const unsigned*)(PG + (size_t)tk * 2304 + 1536 + h * 128 + lane * 2);
        const float o0 = bflo(uf) + bflo(ub), o1 = bfhi(uf) + bfhi(ub);
        const float r = rsqrtf(wave_sum(o0 * o0 + o1 * o1) * (1.f / 128.f) + 1e-6f);
        *(unsigned*)(MIX + o) = cvt_pk_bf16(o0 * r * n0 * silu(bflo(uz)), o1 * r * n1 * silu(bfhi(uz)));
    }
    const bf16_t* YA = (const bf16_t*)((unsigned char*)p.out + DO_YA); bf16_t* tl = (bf16_t*)lds;
    for (int tile = bid; tile < 8 * 256; tile += nb) { const int c0 = (tile & 7) * 64, t0 = (tile >> 3) * 64;
        { const int cr = tid >> 3, tc = tid & 7; *(uint4*)(tl + cr * 72 + tc * 8) = *(const uint4*)(YA + (size_t)(c0 + cr) * 16384 + t0 + tc * 8); }
        __syncthreads();
        { const int r = tid >> 3, cc = tid & 7; u32x4 w; unsigned short v[8];
#pragma unroll
          for (int i = 0; i < 8; ++i) v[i] = tl[(cc * 8 + i) * 72 + r];
          w.x = v[0] | ((unsigned)v[1] << 16); w.y = v[2] | ((unsigned)v[3] << 16); w.z = v[4] | ((unsigned)v[5] << 16); w.w = v[6] | ((unsigned)v[7] << 16);
          *(u32x4*)(MIX + (size_t)(t0 + r) * 1024 + c0 + cc * 8) = w; }
        __syncthreads();
    }
}

template <bool FINAL> __device__ __forceinline__ void phase_ln(const float* TMP, const float* g, const float* bt, bf16_t* XB, float* outf, int tid, int bid, int nb) {
    const int wave = tid >> 6, lane = tid & 63;
#pragma unroll 2
    for (int row = bid * 8 + wave; row < 16384; row += nb * 8) {
        float4 v[4]; float sm = 0.f;
#pragma unroll
        for (int i = 0; i < 4; ++i) { v[i] = *(const float4*)(TMP + (size_t)row * 1024 + i * 256 + lane * 4); sm += (v[i].x + v[i].y) + (v[i].z + v[i].w); }
        const float mean = wave_sum(sm) * (1.f / 1024.f); float sq = 0.f;
#pragma unroll
        for (int i = 0; i < 4; ++i) { v[i].x -= mean; v[i].y -= mean; v[i].z -= mean; v[i].w -= mean; sq += (v[i].x * v[i].x + v[i].y * v[i].y) + (v[i].z * v[i].z + v[i].w * v[i].w); }
        const float r = rsqrtf(wave_sum(sq) * (1.f / 1024.f) + 1e-5f);
#pragma unroll
        for (int i = 0; i < 4; ++i) { const int col = i * 256 + lane * 4; const float4 gg = *(const float4*)(g + col), bb = *(const float4*)(bt + col);
            const float y0 = v[i].x * r * gg.x + bb.x, y1 = v[i].y * r * gg.y + bb.y, y2 = v[i].z * r * gg.z + bb.z, y3 = v[i].w * r * gg.w + bb.w;
            if (FINAL) *(float4*)(outf + (size_t)row * 1024 + col) = make_float4(y0, y1, y2, y3);
            else { uint2 o; o.x = cvt_pk_bf16(y0, y1); o.y = cvt_pk_bf16(y2, y3); *(uint2*)(XB + (size_t)row * 1024 + col) = o; } }
    }
}

__device__ __forceinline__ float rw_shift(const bf16_t* P1, const float* mu, int tk, int t, int idx) {
    const bf16_t* q = P1 + (size_t)tk * 4352 + 2560 + idx;
    const float u = bf1(q[0]), pv = t > 0 ? bf1(q[-4352]) : 0.f, nx = t < 4095 ? bf1(q[4352]) : 0.f;
    return u + mu[idx] * (pv - u) + mu[1792 + idx] * (nx - u); }

__device__ __forceinline__ void phase_rw_lora(const Params& p, float* lds, int tid, int bid, int nb) {
    const bf16_t* P1 = (const bf16_t*)(p.ws + OFF_P); const float* mu = p.in[21];
    bf16_t* DW0 = (bf16_t*)((unsigned char*)p.out + DO_DW0); bf16_t* DW1 = (bf16_t*)((unsigned char*)p.out + DO_DW1); bf16_t* AA = (bf16_t*)(p.ws + OFF_AA);
    const float* w2 = p.in[23]; const float* a2 = p.in[25];
    float* tw = lds; float* al = lds + 1024;
    for (int it = bid; it < 1024; it += nb) {
#pragma unroll
        for (int k = 0; k < 2; ++k) { const int idx = tid + 512 * k, tt = idx >> 6, c = idx & 63, tk = it * 16 + tt, t = tk & 4095;
            tw[c * 16 + tt] = tanhf(rw_shift(P1, mu, tk, t, 1536 + c)); al[c * 16 + tt] = rw_shift(P1, mu, tk, t, 1600 + c); }
        __syncthreads();
        float a0[16], a1[16], aa[16];
#pragma unroll
        for (int i = 0; i < 16; ++i) { a0[i] = 0.f; a1[i] = 0.f; aa[i] = 0.f; }
#pragma unroll 2
        for (int r = 0; r < 64; ++r) { const float x0 = w2[r * 512 + tid], x1 = w2[32768 + r * 512 + tid], xa = a2[r * 512 + tid];
#pragma unroll
            for (int i4 = 0; i4 < 4; ++i4) { const float4 tv = *(const float4*)(tw + r * 16 + i4 * 4), av = *(const float4*)(al + r * 16 + i4 * 4);
                a0[i4 * 4 + 0] += tv.x * x0; a0[i4 * 4 + 1] += tv.y * x0; a0[i4 * 4 + 2] += tv.z * x0; a0[i4 * 4 + 3] += tv.w * x0;
                a1[i4 * 4 + 0] += tv.x * x1; a1[i4 * 4 + 1] += tv.y * x1; a1[i4 * 4 + 2] += tv.z * x1; a1[i4 * 4 + 3] += tv.w * x1;
                aa[i4 * 4 + 0] += av.x * xa; aa[i4 * 4 + 1] += av.y * xa; aa[i4 * 4 + 2] += av.z * xa; aa[i4 * 4 + 3] += av.w * xa; } }
#pragma unroll
        for (int i = 0; i < 16; ++i) { const size_t o = (size_t)(it * 16 + i) * 512 + tid; DW0[o] = f2bf(a0[i]); DW1[o] = f2bf(a1[i]); AA[o] = f2bf(aa[i]); }
        __syncthreads();
    }
}

#define SCAN_TOK(sg) (b * 4096 + (dir ? 4095 - (sg) : (sg)))
#define SCAN_FLUSH(tile_, bsel_, colbase_) { const int stp = tid >> 4, pr = tid & 15; const int tk = SCAN_TOK((tile_) * 16 + stp); \
        *(unsigned*)(OUT + (size_t)tk * 1024 + (colbase_) + pr * 2) = cvt_pk_bf16(ot[(((bsel_) * 16 + stp) * 32 + pr * 2) * 8], ot[(((bsel_) * 16 + stp) * 32 + pr * 2 + 1) * 8]); }

__device__ __forceinline__ void gdn_scan(const Params& p, int item, float* lds, int tid) {
    const int dir = item >> 6, b = (item >> 4) & 3, h = (item >> 2) & 3, sl = item & 3;
    float* kq = lds; float* vv = lds + 8448; float* sc = vv + 1024; float* ot = sc + 64;
    const bf16_t* QK = (const bf16_t*)(p.ws + OFF_QKVP); const float* SC = (const float*)(p.ws + OFF_SC);
    bf16_t* OUT = dir ? (bf16_t*)((unsigned char*)p.out + DO_OB) : (bf16_t*)(p.ws + OFF_MIX);
    if (tid >= 256) {
        const int lt = tid - 256, st = lt >> 4, pp = lt & 15;
        uint4 aq, ak, av = make_uint4(0, 0, 0, 0), bq = av, bk = av, bv = av; float4 as = make_float4(0.f, 0.f, 0.f, 0.f), bs = as;
#define GL(tile, q_, k_, v_, s_) { const int tk_ = SCAN_TOK((tile) * 16 + st); const bf16_t* row_ = QK + (size_t)tk_ * 1536 + h * 128; \
            q_ = *(const uint4*)(row_ + pp * 8); k_ = *(const uint4*)(row_ + 512 + pp * 8); \
            if (pp < 4) v_ = *(const uint4*)(row_ + 1024 + sl * 32 + pp * 8); \
            if (pp == 4) s_ = *(const float4*)(SC + ((size_t)tk_ * 4 + h) * 4); }
#define GS(buf, q_, k_, v_, s_) { const int el_ = pp * 8, o_ = ((buf) * 16 + st) * 264 + el_ + ((el_ >> 6) << 2); unpack8(k_, kq + o_); unpack8(q_, kq + o_ + 132); \
            if (pp < 4) unpack8(v_, vv + ((buf) * 16 + st) * 32 + pp * 8); \
            if (pp == 4) { sc[((buf) * 16 + st) * 2] = s_.x; sc[((buf) * 16 + st) * 2 + 1] = dir ? s_.z : s_.y; } }
        GL(0, aq, ak, av, as); GS(0, aq, ak, av, as); GL(1, aq, ak, av, as);
        __syncthreads();
        for (int tile = 0; tile < 256; ++tile) {
            if (tile + 2 < 256) GL(tile + 2, bq, bk, bv, bs);
            if (tile + 1 < 256) GS((tile + 1) & 1, aq, ak, av, as);
            aq = bq; ak = bk; av = bv; as = bs;
            __syncthreads();
        }
#undef GL
#undef GS
    } else {
        __builtin_amdgcn_s_setprio(3);
        const int e = tid >> 3, j = tid & 7;
        f32x2_t s2[8];
#pragma unroll
        for (int i = 0; i < 8; ++i) s2[i] = (f32x2_t){0.f, 0.f};
        __syncthreads();
        for (int tile = 0; tile < 256; ++tile) {
            const int buf = tile & 1;
            if (tile > 0) SCAN_FLUSH(tile - 1, buf ^ 1, 512 + h * 128 + sl * 32);
            float oreg[16];
            f32x2_t kb[3][8], qb[3][8]; float vb[3], bb[3], gb[3];
#define GDN_LDSTEP(step_, sl_) { const float* kp = kq + (buf * 16 + (step_)) * 264 + j * 16 + ((j >> 2) << 2); \
                _Pragma("unroll") for (int i = 0; i < 4; ++i) { const float4 qv = *(const float4*)(kp + 132 + 4 * i); qb[sl_][2 * i] = (f32x2_t){qv.x, qv.y}; qb[sl_][2 * i + 1] = (f32x2_t){qv.z, qv.w}; } \
                vb[sl_] = vv[(buf * 16 + (step_)) * 32 + e]; bb[sl_] = sc[(buf * 16 + (step_)) * 2]; gb[sl_] = sc[(buf * 16 + (step_)) * 2 + 1]; \
                _Pragma("unroll") for (int i = 0; i < 4; ++i) { const float4 kv = *(const float4*)(kp + 4 * i); kb[sl_][2 * i] = (f32x2_t){kv.x, kv.y}; kb[sl_][2 * i + 1] = (f32x2_t){kv.z, kv.w}; } }
            GDN_LDSTEP(0, 0); GDN_LDSTEP(1, 1);
#pragma unroll
            for (int step = 0; step < 16; ++step) {
                const int cs = step % 3;
                if (step < 14) GDN_LDSTEP(step + 2, (step + 2) % 3);
                asm volatile("" ::: "memory");
                const float ve = vb[cs], beta = bb[cs], g = gb[cs];
                f32x2_t a0 = kb[cs][0] * s2[0], a1 = kb[cs][1] * s2[1];
                a0 = fma2(kb[cs][2], s2[2], a0); a1 = fma2(kb[cs][3], s2[3], a1); a0 = fma2(kb[cs][4], s2[4], a0); a1 = fma2(kb[cs][5], s2[5], a1); a0 = fma2(kb[cs][6], s2[6], a0); a1 = fma2(kb[cs][7], s2[7], a1);
                a0 = a0 + a1;
                const float ks = rowsum8(a0.x + a0.y);
                const float tmp = beta * (ve - g * ks);
                const f32x2_t g2 = (f32x2_t){g, g}, t2 = (f32x2_t){tmp, tmp};
#pragma unroll
                for (int i = 0; i < 8; ++i) s2[i] = fma2(s2[i], g2, kb[cs][i] * t2);
                f32x2_t b0 = qb[cs][0] * s2[0], b1 = qb[cs][1] * s2[1];
                b0 = fma2(qb[cs][2], s2[2], b0); b1 = fma2(qb[cs][3], s2[3], b1); b0 = fma2(qb[cs][4], s2[4], b0); b1 = fma2(qb[cs][5], s2[5], b1); b0 = fma2(qb[cs][6], s2[6], b0); b1 = fma2(qb[cs][7], s2[7], b1);
                b0 = b0 + b1;
                oreg[step] = rowsum8(b0.x + b0.y);
            }
#undef GDN_LDSTEP
#pragma unroll
            for (int step = 0; step < 16; ++step) ot[((buf * 16 + step) * 32 + e) * 8 + j] = oreg[step];
            __syncthreads();
        }
        SCAN_FLUSH(255, 1, 512 + h * 128 + sl * 32);
        __builtin_amdgcn_s_setprio(0);
    }
    __syncthreads();
}

__device__ __forceinline__ void hgrn_scan(const Params& p, int item, float* lds, int tid) {
    const int dir = item >> 6, b = (item >> 4) & 3, h = (item >> 2) & 3, sl = item & 3;
    float* kq = lds; float* vv = lds + 8448; float* ot = vv + 1024;
    const bf16_t* P1 = (const bf16_t*)(p.ws + OFF_P);
    bf16_t* OUT = dir ? (bf16_t*)((unsigned char*)p.out + DO_OB) : (bf16_t*)(p.ws + OFF_MIX);
    if (tid >= 256) {
        const int lt = tid - 256, st = lt >> 4, pp = lt & 15;
        float lb[8];
        { const int cb = h * 128 + pp * 8;
#pragma unroll
          for (int i = 0; i < 8; ++i) lb[i] = sigm(p.in[19][512 + cb + i] - p.in[19][cb + i]); }
        uint4 aq, af, av = make_uint4(0, 0, 0, 0), bq = av, bf_ = av, bv = av;
#define HL(tile, q_, f_, v_) { const int tk_ = SCAN_TOK((tile) * 16 + st); const bf16_t* row_ = P1 + (size_t)tk_ * 4352 + h * 128; \
            q_ = *(const uint4*)(row_ + pp * 8); f_ = *(const uint4*)(row_ + 512 + dir * 512 + pp * 8); \
            if (pp < 4) v_ = *(const uint4*)(row_ + 1536 + sl * 32 + pp * 8); }
#define HS(buf, q_, f_, v_) { float t8[8], u8[8]; \
            t8[0] = bflo(q_.x); t8[1] = bfhi(q_.x); t8[2] = bflo(q_.y); t8[3] = bfhi(q_.y); t8[4] = bflo(q_.z); t8[5] = bfhi(q_.z); t8[6] = bflo(q_.w); t8[7] = bfhi(q_.w); \
            u8[0] = bflo(f_.x); u8[1] = bfhi(f_.x); u8[2] = bflo(f_.y); u8[3] = bfhi(f_.y); u8[4] = bflo(f_.z); u8[5] = bfhi(f_.z); u8[6] = bflo(f_.w); u8[7] = bfhi(f_.w); \
            _Pragma("unroll") for (int i = 0; i < 8; ++i) { t8[i] = silu(t8[i]); u8[i] = lb[i] + (1.f - lb[i]) * sigm(u8[i]); } \
            const int el_ = pp * 8; float* d_ = kq + ((buf) * 16 + st) * 264 + el_ + ((el_ >> 6) << 2); \
            *(float4*)d_ = make_float4(u8[0], u8[1], u8[2], u8[3]); *(float4*)(d_ + 4) = make_float4(u8[4], u8[5], u8[6], u8[7]); \
            *(float4*)(d_ + 132) = make_float4(t8[0], t8[1], t8[2], t8[3]); *(float4*)(d_ + 136) = make_float4(t8[4], t8[5], t8[6], t8[7]); \
            if (pp < 4) unpack8(v_, vv + ((buf) * 16 + st) * 32 + pp * 8); }
        uint4 cq = av, cf = av, cv = av;
        HL(0, aq, af, av); HS(0, aq, af, av); HL(1, aq, af, av); HL(2, bq, bf_, bv);
        __syncthreads();
        for (int tile = 0; tile < 256; ++tile) {
            if (tile + 3 < 256) HL(tile + 3, cq, cf, cv);
            if (tile + 1 < 256) HS((tile + 1) & 1, aq, af, av);
            aq = bq; af = bf_; av = bv; bq = cq; bf_ = cf; bv = cv;
            __syncthreads();
        }
#undef HL
#undef HS
    } else {
        __builtin_amdgcn_s_setprio(3);
        const int e = tid >> 3, j = tid & 7;
        f32x2_t s2[8];
#pragma unroll
        for (int i = 0; i < 8; ++i) s2[i] = (f32x2_t){0.f, 0.f};
        __syncthreads();
        for (int tile = 0; tile < 256; ++tile) {
            const int buf = tile & 1;
            if (tile > 0) SCAN_FLUSH(tile - 1, buf ^ 1, h * 128 + sl * 32);
            float oreg[16];
            f32x2_t fb[3][8], qb[3][8]; float vb[3];
#define HG_LDSTEP(step_, sl_) { const float* kp = kq + (buf * 16 + (step_)) * 264 + j * 16 + ((j >> 2) << 2); \
                _Pragma("unroll") for (int i = 0; i < 4; ++i) { const float4 qv = *(const float4*)(kp + 132 + 4 * i); qb[sl_][2 * i] = (f32x2_t){qv.x, qv.y}; qb[sl_][2 * i + 1] = (f32x2_t){qv.z, qv.w}; } \
                vb[sl_] = vv[(buf * 16 + (step_)) * 32 + e]; \
                _Pragma("unroll") for (int i = 0; i < 4; ++i) { const float4 kv = *(const float4*)(kp + 4 * i); fb[sl_][2 * i] = (f32x2_t){kv.x, kv.y}; fb[sl_][2 * i + 1] = (f32x2_t){kv.z, kv.w}; } }
            HG_LDSTEP(0, 0); HG_LDSTEP(1, 1);
#pragma unroll
            for (int step = 0; step < 16; ++step) {
                const int cs = step % 3;
                if (step < 14) HG_LDSTEP(step + 2, (step + 2) % 3);
                asm volatile("" ::: "memory");
                const f32x2_t v2 = (f32x2_t){vb[cs], vb[cs]};
#pragma unroll
                for (int i = 0; i < 8; ++i) s2[i] = fma2(fb[cs][i], s2[i] - v2, v2);
                f32x2_t b0 = qb[cs][0] * s2[0], b1 = qb[cs][1] * s2[1];
                b0 = fma2(qb[cs][2], s2[2], b0); b1 = fma2(qb[cs][3], s2[3], b1); b0 = fma2(qb[cs][4], s2[4], b0); b1 = fma2(qb[cs][5], s2[5], b1); b0 = fma2(qb[cs][6], s2[6], b0); b1 = fma2(qb[cs][7], s2[7], b1);
                b0 = b0 + b1;
                oreg[step] = rowsum8(b0.x + b0.y);
            }
#undef HG_LDSTEP
#pragma unroll
            for (int step = 0; step < 16; ++step) ot[((buf * 16 + step) * 32 + e) * 8 + j] = oreg[step];
            __syncthreads();
        }
        SCAN_FLUSH(255, 1, h * 128 + sl * 32);
        __builtin_amdgcn_s_setprio(0);
    }
    __syncthreads();
}

__device__ __forceinline__ void rwkv_scan(const Params& p, int item, float* lds, int tid) {
    const int dir = item >> 6, b = (item >> 4) & 3, hh = (item >> 1) & 7, half = item & 1;
    float* tl = lds;
    float* ot = lds + 2 * 16 * 384;
    const bf16_t* P1 = (const bf16_t*)(p.ws + OFF_P);
    bf16_t* OUT = dir ? (bf16_t*)((unsigned char*)p.out + DO_OB) : (bf16_t*)(p.ws + OFF_MIX);
    if (tid >= 256) {
        const bf16_t* DW = (const bf16_t*)((unsigned char*)p.out + (dir ? DO_DW1 : DO_DW0)); const bf16_t* AA = (const bf16_t*)(p.ws + OFF_AA);
        const int lt = tid - 256, st = lt >> 4, cq = lt & 15, ch = hh * 64 + cq * 4;
        const float* mu = p.in[21];
        float m0[3][4], m1[3][4], a0c[4], w0c[4], kkc[4], kac[4];
#pragma unroll
        for (int q = 0; q < 4; ++q) {
#pragma unroll
            for (int s3 = 0; s3 < 3; ++s3) { m0[s3][q] = mu[s3 * 512 + ch + q]; m1[s3][q] = mu[1792 + s3 * 512 + ch + q]; }
            a0c[q] = p.in[24][ch + q]; w0c[q] = p.in[22][dir * 512 + ch + q]; kkc[q] = p.in[27][ch + q]; kac[q] = p.in[28][ch + q]; }
        uint2 au[3][3], bu[3][3], adw, ada, bdw, bda;
#define RL(tile, u_, dw_, da_) { const int tk_ = SCAN_TOK((tile) * 16 + st), t_ = tk_ & 4095; const bf16_t* row_ = P1 + (size_t)tk_ * 4352 + 2560 + ch; \
            const int po_ = t_ > 0 ? -4352 : 0, no_ = t_ < 4095 ? 4352 : 0; \
            _Pragma("unroll") for (int s3 = 0; s3 < 3; ++s3) { u_[1][s3] = *(const uint2*)(row_ + s3 * 512); u_[0][s3] = *(const uint2*)(row_ + po_ + s3 * 512); u_[2][s3] = *(const uint2*)(row_ + no_ + s3 * 512); \
                if (t_ == 0) u_[0][s3] = make_uint2(0u, 0u); if (t_ == 4095) u_[2][s3] = make_uint2(0u, 0u); } \
            dw_ = *(const uint2*)(DW + (size_t)tk_ * 512 + ch); da_ = *(const uint2*)(AA + (size_t)tk_ * 512 + ch); }
#define RS(buf, u_, dw_, da_) { float us[3][4], pv[4], nx[4], cu[4]; \
            _Pragma("unroll") for (int s3 = 0; s3 < 3; ++s3) { \
                cu[0] = bflo(u_[1][s3].x); cu[1] = bfhi(u_[1][s3].x); cu[2] = bflo(u_[1][s3].y); cu[3] = bfhi(u_[1][s3].y); \
                pv[0] = bflo(u_[0][s3].x); pv[1] = bfhi(u_[0][s3].x); pv[2] = bflo(u_[0][s3].y); pv[3] = bfhi(u_[0][s3].y); \
                nx[0] = bflo(u_[2][s3].x); nx[1] = bfhi(u_[2][s3].x); nx[2] = bflo(u_[2][s3].y); nx[3] = bfhi(u_[2][s3].y); \
                _Pragma("unroll") for (int q = 0; q < 4; ++q) us[s3][q] = cu[q] + m0[s3][q] * (pv[q] - cu[q]) + m1[s3][q] * (nx[q] - cu[q]); } \
            float dwv[4], dav[4], av[4], dc[4], kr[4]; \
            dwv[0] = bflo(dw_.x); dwv[1] = bfhi(dw_.x); dwv[2] = bflo(dw_.y); dwv[3] = bfhi(dw_.y); dav[0] = bflo(da_.x); dav[1] = bfhi(da_.x); dav[2] = bflo(da_.y); dav[3] = bfhi(da_.y); \
            float ss = 0.f; \
            _Pragma("unroll") for (int q = 0; q < 4; ++q) { av[q] = sigm(a0c[q] + dav[q]); dc[q] = __expf(-0.6065306597126334f * sigm(w0c[q] + dwv[q])); kr[q] = us[1][q] * kkc[q]; ss += kr[q] * kr[q]; } \
            ss = rowsum16(ss); const float rn = rsqrtf(ss + 1e-6f); \
            float* d_ = tl + ((buf) * 16 + st) * 384 + cq * 4; \
            *(float4*)(d_) = make_float4(us[0][0], us[0][1], us[0][2], us[0][3]); *(float4*)(d_ + 64) = make_float4(dc[0], dc[1], dc[2], dc[3]); \
            *(float4*)(d_ + 128) = make_float4(us[1][0] * (1.f + (av[0] - 1.f) * kac[0]), us[1][1] * (1.f + (av[1] - 1.f) * kac[1]), us[1][2] * (1.f + (av[2] - 1.f) * kac[2]), us[1][3] * (1.f + (av[3] - 1.f) * kac[3])); \
            *(float4*)(d_ + 192) = make_float4(kr[0] * rn, kr[1] * rn, kr[2] * rn, kr[3] * rn); *(float4*)(d_ + 256) = make_float4(kr[0] * rn * av[0], kr[1] * rn * av[1], kr[2] * rn * av[2], kr[3] * rn * av[3]); \
            *(float4*)(d_ + 320) = make_float4(us[2][0], us[2][1], us[2][2], us[2][3]); }
        RL(0, au, adw, ada); RS(0, au, adw, ada); RL(1, au, adw, ada);
        __syncthreads();
        for (int tile = 0; tile < 256; ++tile) {
            if (tile + 2 < 256) RL(tile + 2, bu, bdw, bda);
            if (tile + 1 < 256) RS((tile + 1) & 1, au, adw, ada);
#pragma unroll
            for (int a = 0; a < 3; ++a)
#pragma unroll
                for (int c = 0; c < 3; ++c) au[a][c] = bu[a][c];
            adw = bdw; ada = bda;
            __syncthreads();
        }
#undef RL
#undef RS
    } else {
        __builtin_amdgcn_s_setprio(3);
        const int e = tid >> 3, j = tid & 7, vrow = half * 32 + e;
        f32x2_t s2[4];
#pragma unroll
        for (int i = 0; i < 4; ++i) s2[i] = (f32x2_t){0.f, 0.f};
        __syncthreads();
        for (int tile = 0; tile < 256; ++tile) {
            const int buf = tile & 1;
            if (tile > 0) SCAN_FLUSH(tile - 1, buf ^ 1, 512 + hh * 64 + half * 32);
            float oreg[16];
            f32x2_t rb[3][4], wb[3][4], kb[3][4], kkb[3][4], kab[3][4]; float vb[3];
#define RW_LDSTEP(step_, sl_) { const float* bp = tl + (buf * 16 + (step_)) * 384 + j * 8; \
                _Pragma("unroll") for (int i = 0; i < 2; ++i) { const float4 rv = *(const float4*)(bp + 4 * i), wv = *(const float4*)(bp + 64 + 4 * i), kv = *(const float4*)(bp + 128 + 4 * i), kav = *(const float4*)(bp + 256 + 4 * i); \
                    rb[sl_][2 * i] = (f32x2_t){rv.x, rv.y}; rb[sl_][2 * i + 1] = (f32x2_t){rv.z, rv.w}; wb[sl_][2 * i] = (f32x2_t){wv.x, wv.y}; wb[sl_][2 * i + 1] = (f32x2_t){wv.z, wv.w}; \
                    kb[sl_][2 * i] = (f32x2_t){kv.x, kv.y}; kb[sl_][2 * i + 1] = (f32x2_t){kv.z, kv.w}; kab[sl_][2 * i] = (f32x2_t){kav.x, kav.y}; kab[sl_][2 * i + 1] = (f32x2_t){kav.z, kav.w}; } \
                vb[sl_] = tl[(buf * 16 + (step_)) * 384 + 320 + vrow]; \
                _Pragma("unroll") for (int i = 0; i < 2; ++i) { const float4 kkv = *(const float4*)(bp + 192 + 4 * i); kkb[sl_][2 * i] = (f32x2_t){kkv.x, kkv.y}; kkb[sl_][2 * i + 1] = (f32x2_t){kkv.z, kkv.w}; } }
            RW_LDSTEP(0, 0); RW_LDSTEP(1, 1);
#pragma unroll
            for (int step = 0; step < 16; ++step) {
                const int cs = step % 3;
                if (step < 14) RW_LDSTEP(step + 2, (step + 2) % 3);
                asm volatile("" ::: "memory");
                f32x2_t a0 = kkb[cs][0] * s2[0], a1 = kkb[cs][1] * s2[1]; a0 = fma2(kkb[cs][2], s2[2], a0); a1 = fma2(kkb[cs][3], s2[3], a1); a0 = a0 + a1;
                const float sa = rowsum8(a0.x + a0.y);
                const f32x2_t nsa = (f32x2_t){-sa, -sa}, v2 = (f32x2_t){vb[cs], vb[cs]};
#pragma unroll
                for (int i = 0; i < 4; ++i) s2[i] = fma2(v2, kb[cs][i], fma2(nsa, kab[cs][i], s2[i] * wb[cs][i]));
                f32x2_t b0 = rb[cs][0] * s2[0], b1 = rb[cs][1] * s2[1]; b0 = fma2(rb[cs][2], s2[2], b0); b1 = fma2(rb[cs][3], s2[3], b1); b0 = b0 + b1;
                oreg[step] = rowsum8(b0.x + b0.y);
            }
#undef RW_LDSTEP
#pragma unroll
            for (int step = 0; step < 16; ++step) ot[((buf * 16 + step) * 32 + e) * 8 + j] = oreg[step];
            __syncthreads();
        }
        SCAN_FLUSH(255, 1, 512 + hh * 64 + half * 32);
        __builtin_amdgcn_s_setprio(0);
    }
    __syncthreads();
}
#undef SCAN_TOK
#undef SCAN_FLUSH

__device__ __forceinline__ void phase_post1(const Params& p, float* lds, int tid, int bid, int nb) {
    const int wave = tid >> 6, lane = tid & 63;
    bf16_t* MIX = (bf16_t*)(p.ws + OFF_MIX); const bf16_t* OB = (const bf16_t*)((unsigned char*)p.out + DO_OB); const bf16_t* P1 = (const bf16_t*)(p.ws + OFF_P);
    { const float* nw = p.in[20]; const float n0 = nw[lane * 2], n1 = nw[lane * 2 + 1];
#pragma unroll 4
      for (int it = bid * 8 + wave; it < 16384 * 4; it += nb * 8) {
          const int tk = it >> 2, h = it & 3; const size_t o = (size_t)tk * 1024 + h * 128 + lane * 2;
          const unsigned uf = *(const unsigned*)(MIX + o), ub = *(const unsigned*)(OB + o), uz = *(const unsigned*)(P1 + (size_t)tk * 4352 + 2048 + h * 128 + lane * 2);
          const float o0 = bflo(uf) + bflo(ub), o1 = bfhi(uf) + bfhi(ub);
          const float r = rsqrtf(wave_sum(o0 * o0 + o1 * o1) * (1.f / 128.f) + 1e-6f);
          *(unsigned*)(MIX + o) = cvt_pk_bf16(o0 * r * n0 * silu(bflo(uz)), o1 * r * n1 * silu(bfhi(uz))); } }
    { const float* mu = p.in[21]; const float* g2 = p.in[26]; const bf16_t* AA = (const bf16_t*)(p.ws + OFF_AA);
      const int ch = tid; float* sg = lds;
      const float a0 = p.in[24][ch], kac = p.in[28][ch], rk = p.in[29][ch], lw = p.in[30][ch], lbv = p.in[31][ch];
      const float m0r = mu[ch], m0k = mu[512 + ch], m0v = mu[1024 + ch], m1r = mu[1792 + ch], m1k = mu[1792 + 512 + ch], m1v = mu[1792 + 1024 + ch];
      for (int it = bid; it < 1024; it += nb) {
#pragma unroll
          for (int k = 0; k < 4; ++k) { const int idx = tid + 512 * k, tt = idx >> 7, r = idx & 127, tk = it * 16 + tt; sg[r * 16 + tt] = sigm(rw_shift(P1, mu, tk, tk & 4095, 1664 + r)); }
          __syncthreads();
          float acc[16];
#pragma unroll
          for (int i = 0; i < 16; ++i) acc[i] = 0.f;
#pragma unroll 4
          for (int r = 0; r < 128; ++r) { const float gv = g2[r * 512 + ch];
#pragma unroll
              for (int i4 = 0; i4 < 4; ++i4) { const float4 sv = *(const float4*)(sg + r * 16 + i4 * 4);
                  acc[i4 * 4 + 0] += sv.x * gv; acc[i4 * 4 + 1] += sv.y * gv; acc[i4 * 4 + 2] += sv.z * gv; acc[i4 * 4 + 3] += sv.w * gv; } }
#pragma unroll
          for (int i = 0; i < 16; ++i) { const int tk = it * 16 + i, t = tk & 4095;
              const bf16_t* q = P1 + (size_t)tk * 4352 + 2560 + ch;
              const bool hp = t > 0, hn = t < 4095; const int po = hp ? -4352 : 0, no = hn ? 4352 : 0;
              const float fr = bf1(q[0]), fk = bf1(q[512]), fv = bf1(q[1024]);
              const float pr_ = bf1(q[po]), pk_ = bf1(q[po + 512]), pv_ = bf1(q[po + 1024]), nr_ = bf1(q[no]), nk_ = bf1(q[no + 512]), nv_ = bf1(q[no + 1024]);
              const float rs = fr + m0r * ((hp ? pr_ : 0.f) - fr) + m1r * ((hn ? nr_ : 0.f) - fr);
              const float ks = fk + m0k * ((hp ? pk_ : 0.f) - fk) + m1k * ((hn ? nk_ : 0.f) - fk);
              const float vs = fv + m0v * ((hp ? pv_ : 0.f) - fv) + m1v * ((hn ? nv_ : 0.f) - fv);
              const float av = sigm(a0 + bf1(AA[(size_t)tk * 512 + ch])); const float kp = ks * (1.f + (av - 1.f) * kac);
              const size_t o = (size_t)tk * 1024 + 512 + ch;
              const float y = bf1(MIX[o]) + bf1(OB[o]);
              float d0 = rs * kp * rk, d1 = y;
#pragma unroll
              for (int sh = 32; sh >= 1; sh >>= 1) { d0 += __shfl_xor(d0, sh); d1 += __shfl_xor(d1, sh); }
              const float yc = y - d1 * (1.f / 64.f); const float var = wave_sum(yc * yc) * (1.f / 64.f);
              const float yn = yc * rsqrtf(var + 64e-5f) * lw + lbv;
              MIX[o] = f2bf((yn + d0 * vs) * acc[i]);
              if ((i & 3) == 3) __builtin_amdgcn_sched_barrier(0); }
          __syncthreads();
      } }
}


__global__ void __launch_bounds__(512, 2) hybrid_fwd(Params p) {
    extern __shared__ __attribute__((aligned(16))) unsigned char shm[];
    cg::grid_group grid = cg::this_grid();
    const int tid = threadIdx.x, bid = blockIdx.x, nb = gridDim.x;
    float* lds = (float*)shm; unsigned char* ws = p.ws;
    bf16_t* XB = (bf16_t*)(ws + OFF_XB); bf16_t* MIX = (bf16_t*)(ws + OFF_MIX); bf16_t* Pb = (bf16_t*)(ws + OFF_P); float* TMPP = (float*)(ws + OFF_P);
    const float* lng = p.in[33]; const float* lnb = p.in[34];

    volatile LAS unsigned* xst = (volatile LAS unsigned*)(shm + 131072 + 1024);
    if (tid < 4) xst[tid] = 0u;
    __syncthreads();
    const XcdBarrier xb = xcd_barrier_post((unsigned*)(ws + OFF_BAR), xst);
    phase_prep(p, lds, tid, bid, nb);
    xcd_barrier(xb);
    { EpiBf<0> e1; e1.O = (bf16_t*)(ws + OFF_PH); e1.ldc = 16384; run_gemm(shm, (const bf16_t*)(ws + OFF_EV_IN), XB, 1536, 16384, 1024, e1, bid);
      EpiBf<0> e2; e2.O = (bf16_t*)(ws + OFF_PG); e2.ldc = 2304; run_gemm(shm, XB, (const bf16_t*)(ws + OFF_EV_IN) + (size_t)1536 * 1024, 16384, 2304, 1024, e2, (bid + (nb >> 1)) % nb); }
    xcd_barrier(xb);
    phase_gdn_prep(p, tid, bid, nb);
    xcd_barrier(xb);
    if (bid < 128) gdn_scan(p, bid, lds, tid);
    else { for (int c = bid - 128; c < 512; c += nb - 128) hyena_channel(p, c, bid - 128, lds, tid);
           prep_weights_a(p, lds, tid, bid - 128, nb - 128); }
    grid.sync();
    phase_post0(p, lds, tid, bid, nb);
    xcd_barrier(xb);
    { EpiRes<false> e; e.C = TMPP; e.res = p.in[0]; run_gemm(shm, MIX, (const bf16_t*)(ws + OFF_EV_OUT), 16384, 1024, 1024, e, bid); }
    xcd_barrier(xb);
    phase_ln<false>(TMPP, lng, lnb, XB, nullptr, tid, bid, nb);
    xcd_barrier(xb);
    { EpiBf<1> e; e.O = Pb; e.ldc = 4096; run_gemm(shm, XB, (const bf16_t*)(ws + OFF_W1_0), 16384, 4096, 1024, e, bid); }
    xcd_barrier(xb);
    { EpiRes<true> e; e.C = p.out; e.res = XB; run_gemm(shm, Pb, (const bf16_t*)(ws + OFF_W2_0), 16384, 1024, 4096, e, bid); }
    xcd_barrier(xb);
    phase_ln<false>(p.out, lng + 1024, lnb + 1024, XB, nullptr, tid, bid, nb);
    xcd_barrier(xb);
    { EpiBf<0> e; e.O = Pb; e.ldc = 4352; run_gemm(shm, XB, (const bf16_t*)(ws + OFF_OD_IN), 16384, 4352, 1024, e, bid); }
    xcd_barrier(xb);
    phase_rw_lora(p, lds, tid, bid, nb);
    xcd_barrier(xb);
    if (bid < 128) { hgrn_scan(p, bid, lds, tid); prep_weights_b(p, lds, tid, bid, 128); }
    else for (int it = bid - 128; it < 128; it += nb - 128) rwkv_scan(p, it, lds, tid);
    xcd_barrier(xb);
    phase_post1(p, lds, tid, bid, nb);
    xcd_barrier(xb);
    { EpiRes<true> e; e.C = TMPP; e.res = XB; run_gemm(shm, MIX, (const bf16_t*)(ws + OFF_OD_OUT), 16384, 1024, 1024, e, bid); }
    xcd_barrier(xb);
    phase_ln<false>(TMPP, lng + 2048, lnb + 2048, XB, nullptr, tid, bid, nb);
    xcd_barrier(xb);
    { EpiBf<1> e; e.O = Pb; e.ldc = 4096; run_gemm(shm, XB, (const bf16_t*)(ws + OFF_W1_1), 16384, 4096, 1024, e, bid); }
    xcd_barrier(xb);
    { EpiRes<true> e; e.C = p.out; e.res = XB; run_gemm(shm, Pb, (const bf16_t*)(ws + OFF_W2_1), 16384, 1024, 4096, e, bid); }
    xcd_barrier(xb);
    phase_ln<true>(p.out, lng + 3072, lnb + 3072, nullptr, p.out, tid, bid, nb);
}

extern "C" void kernel_launch(void* const* d_in, const int* in_sizes, int n_in, void* d_out, int out_size, void* d_ws, size_t ws_size, hipStream_t stream) {
    static int grid_blocks = 0;
    if (!grid_blocks) {
        int dev = 0, cus = 0, per_cu = 0;
        hipGetDevice(&dev);
        hipDeviceGetAttribute(&cus, hipDeviceAttributeMultiprocessorCount, dev);
        hipFuncSetAttribute((const void*)hybrid_fwd, hipFuncAttributeMaxDynamicSharedMemorySize, LDS_BYTES);
        hipOccupancyMaxActiveBlocksPerMultiprocessor(&per_cu, (const void*)hybrid_fwd, 512, LDS_BYTES);
        if (per_cu < 1) { fprintf(stderr, "kernel_launch: occupancy query says %d blocks per CU\n", per_cu); per_cu = 1; }
        grid_blocks = cus * per_cu;
        if (n_in != 37 || ws_size < 254 * MBy) fprintf(stderr, "kernel_launch: unexpected n_in %d / ws_size %zu\n", n_in, ws_size);
    }
    hipMemsetAsync((unsigned char*)d_ws + OFF_BAR, 0, XCD_BAR_WORDS * sizeof(unsigned), stream);
    Params p{};
    for (int i = 0; i < 37; ++i) p.in[i] = (const float*)d_in[i];
    p.out = (float*)d_out; p.ws = (unsigned char*)d_ws;
    void* args[] = {&p};
    hipError_t e = hipLaunchCooperativeKernel((const void*)hybrid_fwd, dim3(grid_blocks), dim3(512), args, LDS_BYTES, stream);
    if (e != hipSuccess) fprintf(stderr, "cooperative launch failed: %s (grid %d)\n", hipGetErrorString(e), grid_blocks);
}
```

```cpp
#include <hip/hip_runtime.h>
#include <hip/hip_cooperative_groups.h>
#include <cstdio>
namespace cg = cooperative_groups;
namespace pg8 {
#define PG8_LAS __attribute__((address_space(3)))
typedef unsigned short bf16_t;
typedef short bf16x8 __attribute__((ext_vector_type(8)));
typedef float f32x4 __attribute__((ext_vector_type(4)));
typedef unsigned u32x4 __attribute__((ext_vector_type(4)));
constexpr int BM = 256, BK = 64, HALF = 128, HTB = HALF * BK * 2  , STAGE_BYTES = 8 * HTB, NXCD = 8, WGM = 8;

__host__ __device__ __forceinline__ int lds_byte(int r, int c) { const int st = (r >> 4) * 2 + (c >> 5), rr = r & 15, cc = c & 31, ob = rr * 64 + cc * 2; return st * 1024 + (ob ^ (((ob >> 9) & 1) << 5)); }
__host__ __device__ __forceinline__ void stage_rc(int b, int& R, int& C) { const int st = b / 1024, sb = b % 1024, swz = sb ^ (((sb >> 9) & 1) << 5); R = (st >> 1) * 16 + swz / 64; C = (st & 1) * 32 + (swz % 64) / 2; }
__host__ __device__ __forceinline__ int perm32(int rho) { const int n = rho >> 4, i = rho & 15; return 8 * (i >> 2) + 4 * n + (i & 3); }

struct Unit { int pm, pn; };
struct Gemm { const bf16_t* A; const bf16_t* Bt; int M, N, K; };

struct StaticOrder {
    int nM, nN, nwg, G, c;
    __host__ __device__ void init(int M, int N, int G_, int c_) { nM = M / BM; nN = N / BM; nwg = nM * nN; G = G_; c = c_; }
    __host__ __device__ bool next(int i, Unit& u) const {
        const long L = (long)i * G + c; if (L >= nwg) return false;
        int wgid = (int)L; { const int q = nwg / NXCD, r = nwg % NXCD, xcd = wgid % NXCD, off = wgid / NXCD; wgid = (xcd < r ? xcd * (q + 1) : r * (q + 1) + (xcd - r) * q) + off; }
        const int nig = WGM * nN, gid = wgid / nig, fm = gid * WGM, gsz = (nM - fm) < WGM ? (nM - fm) : WGM;
        u.pm = fm + ((wgid % nig) % gsz); u.pn = (wgid % nig) / gsz; return true;
    }
    __device__ __forceinline__ void a_ready(const Unit&) const {}
    __device__ __forceinline__ void done(const Unit&) const {}
};
__device__ __forceinline__ unsigned cvt_pk_bf16(float lo, float hi) { unsigned r; asm volatile("v_cvt_pk_bf16_f32 %0, %1, %2" : "=v"(r) : "v"(lo), "v"(hi)); return r; }
template <class Epi, class Sched>
__device__ __forceinline__ void gemm_phase(PG8_LAS unsigned char* lds, const Gemm g, const Sched& S, const Epi& E) {
    const int tid = threadIdx.x, wid = __builtin_amdgcn_readfirstlane(tid >> 6), lane = tid & 63, wr = wid >> 2, wc = wid & 3, fr = lane & 15, fq = lane >> 4;
    const int K = g.K, nt = K / BK;
    unsigned voffA[2], voffB[2];
#pragma unroll
    for (int i = 0; i < 2; ++i) { int R, C; stage_rc(tid * 16 + i * 8192, R, C); const int Rb = Epi::PERM ? ((R & ~31) + perm32(R & 31)) : R;
        voffA[i] = (unsigned)(R * K + C) * 2u; voffB[i] = (unsigned)(Rb * K + C) * 2u; }
    const size_t kstep = (size_t)(BK * 2);
    const size_t hstep = (size_t)HALF * K * 2;
    const size_t tstep = 2 * hstep;
    const unsigned ldsw = (unsigned)wid * 1024u;
    const int aoff = lds_byte(wr * 64 + fr, fq * 8), boff = lds_byte(wc * 32 + fr, fq * 8);
#define PG8_SA(b, h) (((b) * 2 + (h)) * HTB)
#define PG8_SB(b, h) ((4 + (b) * 2 + (h)) * HTB)
#define PG8_STAGE(bufoff, gbase, voff) do { _Pragma("unroll") for (int _i = 0; _i < 2; ++_i) \
        __builtin_amdgcn_global_load_lds((const unsigned*)((const char*)(gbase) + (voff)[_i]), (PG8_LAS unsigned*)(lds + (bufoff) + ldsw + _i * 8192), 16, 0, 0); } while (0)
#define PG8_LDA(dst, b, h) do { _Pragma("unroll") for (int m = 0; m < 4; ++m) _Pragma("unroll") for (int k = 0; k < 2; ++k) dst[m][k] = *(const PG8_LAS bf16x8*)(lds + PG8_SA(b, h) + aoff + m * 2048 + k * 1024); } while (0)
#define PG8_LDB(dst, b, h) do { _Pragma("unroll") for (int n = 0; n < 2; ++n) _Pragma("unroll") for (int k = 0; k < 2; ++k) dst[n][k] = *(const PG8_LAS bf16x8*)(lds + PG8_SB(b, h) + boff + n * 2048 + k * 1024); } while (0)
#define PG8_MMA(ai, bj, At, Bt) do { __builtin_amdgcn_s_setprio(1); _Pragma("unroll") for (int m = 0; m < 4; ++m) _Pragma("unroll") for (int n = 0; n < 2; ++n) _Pragma("unroll") for (int k = 0; k < 2; ++k) \
        acc[ai][bj][m][n] = __builtin_amdgcn_mfma_f32_16x16x32_bf16(Bt[n][k], At[m][k], acc[ai][bj][m][n], 0, 0, 0); __builtin_amdgcn_s_setprio(0); } while (0)
#define PG8_WAIT_V(n) asm volatile("s_waitcnt vmcnt(" #n ")" ::: "memory")
#define PG8_WAIT_L(n) asm volatile("s_waitcnt lgkmcnt(" #n ")" ::: "memory")
#define PG8_BAR __builtin_amdgcn_s_barrier()
#define PG8_SCHED __builtin_amdgcn_sched_barrier(0)
    Unit cur, nxt; int ui = 0;
    if (!S.next(0, cur)) return;
    f32x4 acc[2][2][4][2];
#pragma unroll
    for (int a = 0; a < 2; ++a)
#pragma unroll
        for (int b = 0; b < 2; ++b)
#pragma unroll
            for (int m = 0; m < 4; ++m)
#pragma unroll
                for (int n = 0; n < 2; ++n) acc[a][b][m][n] = (f32x4){0.f, 0.f, 0.f, 0.f};
    bf16x8 At[4][2], B0[2][2], B1[2][2];
    const char* cA = (const char*)g.A + (size_t)cur.pm * tstep; const char* cB = (const char*)g.Bt + (size_t)cur.pn * tstep;
    S.a_ready(cur);
    PG8_STAGE(PG8_SB(0, 0), cB, voffB); PG8_STAGE(PG8_SA(0, 0), cA, voffA); PG8_STAGE(PG8_SB(0, 1), cB + hstep, voffB); PG8_STAGE(PG8_SA(0, 1), cA + hstep, voffA);
    if (wr == 1) PG8_BAR;
    PG8_WAIT_V(4); PG8_BAR;
    PG8_STAGE(PG8_SB(1, 0), cB + kstep, voffB); PG8_STAGE(PG8_SA(1, 0), cA + kstep, voffA); PG8_STAGE(PG8_SB(1, 1), cB + hstep + kstep, voffB);
    PG8_WAIT_V(6); PG8_BAR;
    for (;;) {
        const bool has_next = S.next(ui + 1, nxt);
        const char* nA = has_next ? (const char*)g.A + (size_t)nxt.pm * tstep : cA; const char* nB = has_next ? (const char*)g.Bt + (size_t)nxt.pn * tstep : cB;
        for (int t = 0; t < nt; t += 2) {
            const bool last = (t == nt - 2);
            const char* a1 = cA + (size_t)(t + 1) * kstep;
            const char* a2 = last ? nA : cA + (size_t)(t + 2) * kstep; const char* b2 = last ? nB : cB + (size_t)(t + 2) * kstep;
            const char* a3 = a2 + kstep; const char* b3 = b2 + kstep;
            if (last && has_next) S.a_ready(nxt);
            PG8_LDB(B0, 0, 0); PG8_SCHED; PG8_LDA(At, 0, 0); PG8_STAGE(PG8_SA(1, 1), a1 + hstep, voffA);
            PG8_WAIT_L(8); PG8_BAR; PG8_WAIT_L(0); PG8_MMA(0, 0, At, B0); PG8_BAR; PG8_SCHED;
            PG8_LDB(B1, 0, 1); PG8_STAGE(PG8_SB(0, 0), b2, voffB);
            PG8_BAR; PG8_WAIT_L(0); PG8_MMA(0, 1, At, B1); PG8_BAR;
            PG8_LDA(At, 0, 1); PG8_STAGE(PG8_SA(0, 0), a2, voffA);
            PG8_BAR; PG8_WAIT_L(0); PG8_MMA(1, 0, At, B0); PG8_BAR; PG8_SCHED;
            PG8_STAGE(PG8_SB(0, 1), b2 + hstep, voffB);
            PG8_WAIT_V(6); PG8_BAR; PG8_MMA(1, 1, At, B1); PG8_BAR;
            PG8_LDB(B0, 1, 0); PG8_SCHED; PG8_LDA(At, 1, 0); PG8_STAGE(PG8_SA(0, 1), a2 + hstep, voffA);
            PG8_WAIT_L(8); PG8_BAR; PG8_WAIT_L(0); PG8_MMA(0, 0, At, B0); PG8_BAR; PG8_SCHED;
            PG8_LDB(B1, 1, 1); PG8_STAGE(PG8_SB(1, 0), b3, voffB);
            PG8_BAR; PG8_WAIT_L(0); PG8_MMA(0, 1, At, B1); PG8_BAR;
            PG8_LDA(At, 1, 1); PG8_STAGE(PG8_SA(1, 0), a3, voffA);
            PG8_BAR; PG8_WAIT_L(0); PG8_MMA(1, 0, At, B0); PG8_BAR; PG8_SCHED;
            PG8_STAGE(PG8_SB(1, 1), b3 + hstep, voffB);
            PG8_WAIT_V(6); PG8_BAR; PG8_MMA(1, 1, At, B1); PG8_BAR;
        }
        if constexpr (!Epi::AFTER_DRAIN) { E(acc, cur, wr, wc, fr, fq); S.done(cur); }
        if (!has_next) break;
#pragma unroll
        for (int a = 0; a < 2; ++a)
#pragma unroll
            for (int b = 0; b < 2; ++b)
#pragma unroll
                for (int m = 0; m < 4; ++m)
#pragma unroll
                    for (int n = 0; n < 2; ++n) acc[a][b][m][n] = (f32x4){0.f, 0.f, 0.f, 0.f};
        cur = nxt; cA = nA; cB = nB; ++ui;
    }
    PG8_WAIT_V(0);
    if (wr == 0) PG8_BAR;
    PG8_BAR;
    if constexpr (Epi::AFTER_DRAIN) { E.fused(acc, cur, wr, wc, fr, fq, lds, wid, lane); S.done(cur); }
#undef PG8_SA
#undef PG8_SB
#undef PG8_STAGE
#undef PG8_LDA
#undef PG8_LDB
#undef PG8_MMA
#undef PG8_WAIT_V
#undef PG8_WAIT_L
#undef PG8_BAR
#undef PG8_SCHED
}
}
#define XB_TMO      128
#define XB_XCNT(j)  (256  + 64 * (j))
#define XB_XSUB(j)  (1280 + 64 * (j))
#define XB_XGEN(j)  (2304 + 64 * (j))
#define XB_TOP      3328
#define XB_TOPGEN   3392
#define XCD_BAR_WORDS 3456
#define XB_SPIN_CAP (1u << 18)
#define LAS __attribute__((address_space(3)))

__device__ __forceinline__ unsigned xb_ld(unsigned* p)              { return __hip_atomic_load(p, __ATOMIC_RELAXED, __HIP_MEMORY_SCOPE_AGENT); }
__device__ __forceinline__ unsigned xb_add(unsigned* p, unsigned v) { return __hip_atomic_fetch_add(p, v, __ATOMIC_RELAXED, __HIP_MEMORY_SCOPE_AGENT); }
__device__ __forceinline__ unsigned xb_xcc_id() { return (unsigned)__builtin_amdgcn_s_getreg((3 << 11) | 20) & 0xFu; }
#define XB_SPIN(cond, bar) do { unsigned _sp = 0; while (cond) { __builtin_amdgcn_s_sleep(1); \
    if ((++_sp & 255u) == 0u) { if (xb_ld(&(bar)[XB_TMO])) break; if (_sp > XB_SPIN_CAP) { atomicAdd(&(bar)[XB_TMO], 1u); break; } } } } while (0)

struct XcdBarrier {
    unsigned* bar; unsigned x;
    volatile LAS unsigned* st;
};

__device__ __forceinline__ XcdBarrier xcd_barrier_post(unsigned* bar, volatile LAS unsigned* st) {
    XcdBarrier b; b.bar = bar; b.x = xb_xcc_id(); b.st = st;
    if (threadIdx.x == 0) (void)xb_add(&bar[XB_XCNT(b.x)], 1u);
    return b;
}
__device__ __forceinline__ void xcd_barrier_complete(unsigned* bar, unsigned x, unsigned& nloc, unsigned& nx) {
    const unsigned G = gridDim.x * gridDim.y * gridDim.z;
    unsigned sum, cnt, mine, sp = 0u;
    for (;;) {
        sum = 0u; cnt = 0u; mine = 0u;
#pragma unroll
        for (unsigned j = 0; j < 16; ++j) { const unsigned c = xb_ld(&bar[XB_XCNT(j)]); sum += c; cnt += (c > 0u) ? 1u : 0u; mine = (j == x) ? c : mine; }
        if (sum == G) break;
        __builtin_amdgcn_s_sleep(1);
        if ((++sp & 255u) == 0u) { if (xb_ld(&bar[XB_TMO])) break; if (sp > XB_SPIN_CAP) { atomicAdd(&bar[XB_TMO], 1u); break; } }
    }
    nloc = mine > 0u ? mine : 1u; nx = cnt > 0u ? cnt : 1u;
}

__device__ __forceinline__ void xcd_barrier(const XcdBarrier& b) {
    asm volatile("s_waitcnt vmcnt(0)" ::: "memory");
    __syncthreads();
    if (threadIdx.x == 0) {
        unsigned* bar = b.bar;
        __builtin_amdgcn_s_waitcnt(0);
        unsigned nloc = b.st[0], nx = b.st[1];
        if (nloc == 0u) { xcd_barrier_complete(bar, b.x, nloc, nx); b.st[0] = nloc; b.st[1] = nx; }
        const unsigned old = xb_add(&bar[XB_XSUB(b.x)], 1u);
        const unsigned gen = old / nloc;
        if (old + 1u == (gen + 1u) * nloc) {
            __builtin_amdgcn_fence(__ATOMIC_RELEASE, "agent");
            asm volatile("s_waitcnt vmcnt(0)" ::: "memory");
            const unsigned og = xb_add(&bar[XB_TOP], 1u);
            const unsigned tg = og / nx;
            if (og + 1u == (tg + 1u) * nx) xb_add(&bar[XB_TOPGEN], 1u);
            else XB_SPIN(xb_ld(&bar[XB_TOPGEN]) == tg, bar);
            __builtin_amdgcn_fence(__ATOMIC_ACQUIRE, "agent");
            xb_add(&bar[XB_XGEN(b.x)], 1u);
            asm volatile("s_waitcnt vmcnt(0)" ::: "memory");
        } else {
            XB_SPIN(xb_ld(&bar[XB_XGEN(b.x)]) == gen, bar);
            __builtin_amdgcn_fence(__ATOMIC_ACQUIRE, "agent");
            asm volatile("s_waitcnt vmcnt(0)" ::: "memory");
        }
    }
    __syncthreads();
}

using pg8::bf16_t; using pg8::f32x4; using pg8::u32x4; using pg8::cvt_pk_bf16;

constexpr size_t MBy = 1048576;
constexpr size_t OFF_OD_IN = 0, OFF_OD_OUT = OFF_OD_IN + 4352ull * 1024 * 2, OFF_W1_1 = OFF_OD_OUT + 2097152ull, OFF_W2_1 = OFF_W1_1 + 8388608ull;
constexpr size_t OFF_WT0 = OFF_W2_1 + 8388608ull;
constexpr size_t OFF_EV_IN = OFF_WT0, OFF_EV_OUT = OFF_EV_IN + 3840ull * 1024 * 2, OFF_W1_0 = OFF_EV_OUT + 2097152ull, OFF_W2_0 = OFF_W1_0 + 8388608ull;
static_assert(OFF_W2_0 + 8388608ull == 52 * MBy, "weights region");
constexpr size_t OFF_P = 52 * MBy, OFF_XB = 188 * MBy, OFF_MIX = 220 * MBy, OFF_H3 = 252 * MBy, OFF_SC = 253 * MBy;
constexpr size_t OFF_PH = OFF_P, OFF_PG = OFF_P + 48 * MBy, OFF_QKVP = OFF_P + 120 * MBy;
constexpr size_t OFF_AA = OFF_WT0;
constexpr size_t DO_OB = 0, DO_YA = 32 * MBy, DO_HF = 48 * MBy, DO_FG1 = 56 * MBy, DO_DW0 = 32 * MBy, DO_DW1 = 48 * MBy;
constexpr int LDS_BYTES = 131072 + 1024 + 16;
constexpr size_t OFF_BAR = 255 * MBy;
constexpr float ALPHA = 1.41421356237f;

struct Params { const float* in[37]; float* out; unsigned char* ws; };

__device__ __forceinline__ float bflo(unsigned u) { return __uint_as_float(u << 16); }
__device__ __forceinline__ float bfhi(unsigned u) { return __uint_as_float(u & 0xffff0000u); }
__device__ __forceinline__ float bf1(bf16_t b) { return __uint_as_float(((unsigned)b) << 16); }
__device__ __forceinline__ bf16_t f2bf(float f) { return (bf16_t)(cvt_pk_bf16(f, 0.f) & 0xffffu); }
__device__ __forceinline__ float sigm(float x) { return 1.f / (1.f + __expf(-x)); }
__device__ __forceinline__ float silu(float x) { return x / (1.f + __expf(-x)); }
__device__ __forceinline__ float wave_sum(float x) {
#pragma unroll
    for (int o = 32; o >= 1; o >>= 1) x += __shfl_xor(x, o);
    return x; }
#define DPP_ADD_ROR(x, ctl) x += __int_as_float(__builtin_amdgcn_update_dpp(0, __float_as_int(x), ctl, 0xf, 0xf, false))
__device__ __forceinline__ float rowsum16(float x) {
    DPP_ADD_ROR(x, 0x128); DPP_ADD_ROR(x, 0x124); DPP_ADD_ROR(x, 0x122); DPP_ADD_ROR(x, 0x121); return x; }
__device__ __forceinline__ float rowsum8(float x) {
    DPP_ADD_ROR(x, 0x141); DPP_ADD_ROR(x, 0xB1); DPP_ADD_ROR(x, 0x4E); return x; }
typedef float f32x2_t __attribute__((ext_vector_type(2)));
__device__ __forceinline__ f32x2_t fma2(f32x2_t a, f32x2_t b, f32x2_t c) { return __builtin_elementwise_fma(a, b, c); }
__device__ __forceinline__ void unpack8(uint4 r, float* d) {
    *(float4*)d = make_float4(bflo(r.x), bfhi(r.x), bflo(r.y), bfhi(r.y));
    *(float4*)(d + 4) = make_float4(bflo(r.z), bfhi(r.z), bflo(r.w), bfhi(r.w)); }

template <int ACT> struct EpiBf {
    static constexpr bool PERM = true, AFTER_DRAIN = false;
    bf16_t* O; int ldc;
    __device__ __forceinline__ void operator()(const f32x4 (&acc)[2][2][4][2], const pg8::Unit& u, int wr, int wc, int fr, int fq) const {
        const int row0 = u.pm * 256 + wr * 64 + fr, col0 = u.pn * 256 + wc * 32 + 8 * fq;
#pragma unroll
        for (int ai = 0; ai < 2; ++ai)
#pragma unroll
            for (int m = 0; m < 4; ++m) { bf16_t* rowp = O + (size_t)(row0 + ai * 128 + m * 16) * ldc + col0;
#pragma unroll
                for (int bj = 0; bj < 2; ++bj) { f32x4 v0 = acc[ai][bj][m][0], v1 = acc[ai][bj][m][1];
                    if (ACT == 1) {
#pragma unroll
                        for (int j = 0; j < 4; ++j) { float a = fmaxf(v0[j], 0.f), b = fmaxf(v1[j], 0.f); v0[j] = a * a; v1[j] = b * b; } }
                    u32x4 w; w.x = cvt_pk_bf16(v0[0], v0[1]); w.y = cvt_pk_bf16(v0[2], v0[3]); w.z = cvt_pk_bf16(v1[0], v1[1]); w.w = cvt_pk_bf16(v1[2], v1[3]);
                    *(u32x4*)(rowp + bj * 128) = w; } }
    }
};
template <bool RESBF> struct EpiRes {
    static constexpr bool PERM = false, AFTER_DRAIN = false;
    float* C; const void* res;
    __device__ __forceinline__ void operator()(const f32x4 (&acc)[2][2][4][2], const pg8::Unit& u, int wr, int wc, int fr, int fq) const {
        const int row0 = u.pm * 256 + wr * 64 + fr, col0 = u.pn * 256 + wc * 32 + 4 * fq;
#pragma unroll
        for (int ai = 0; ai < 2; ++ai)
#pragma unroll
            for (int m = 0; m < 4; ++m) { const size_t ro = (size_t)(row0 + ai * 128 + m * 16) * 1024 + col0;
#pragma unroll
                for (int bj = 0; bj < 2; ++bj)
#pragma unroll
                    for (int n = 0; n < 2; ++n) { const size_t o = ro + bj * 128 + n * 16; f32x4 r;
                        if (RESBF) { const uint2 w = *(const uint2*)((const bf16_t*)res + o); r = (f32x4){bflo(w.x), bfhi(w.x), bflo(w.y), bfhi(w.y)}; }
                        else r = *(const f32x4*)((const float*)res + o);
                        *(f32x4*)(C + o) = acc[ai][bj][m][n] + r * ALPHA; } }
    }
};
template <class Epi> __device__ __forceinline__ void run_gemm(unsigned char* shm, const bf16_t* A, const bf16_t* Bt, int M, int N, int K, const Epi& E, int c) {
    pg8::Gemm g; g.A = A; g.Bt = Bt; g.M = M; g.N = N; g.K = K;
    pg8::StaticOrder S; S.init(M, N, (int)gridDim.x, c);
    pg8::gemm_phase<Epi, pg8::StaticOrder>((PG8_LAS unsigned char*)shm, g, S, E);
    __syncthreads();
}

__device__ __forceinline__ void transpose_mat(const float* __restrict__ W, int K, int N, int Npad, bf16_t* __restrict__ Wt, float* lds, int tid, int bid, int nb) {
    const int ntk = K >> 6, ntiles = (Npad >> 6) * ntk;
    for (int tile = bid; tile < ntiles; tile += nb) {
        const int tn = tile / ntk, tk = tile - tn * ntk, n0 = tn << 6, k0 = tk << 6;
        { const int c4 = tid & 15, r = tid >> 4;
#pragma unroll
          for (int rr = 0; rr < 2; ++rr) { const int row = r + rr * 32, n = n0 + c4 * 4; float4 v = make_float4(0.f, 0.f, 0.f, 0.f);
              if (n < N) v = *(const float4*)(W + (size_t)(k0 + row) * N + n);
              float* d = lds + row * 65 + c4 * 4; d[0] = v.x; d[1] = v.y; d[2] = v.z; d[3] = v.w; } }
        __syncthreads();
        { const int n = tid >> 3, kc = tid & 7; u32x4 w;
          w.x = cvt_pk_bf16(lds[(kc * 8 + 0) * 65 + n], lds[(kc * 8 + 1) * 65 + n]); w.y = cvt_pk_bf16(lds[(kc * 8 + 2) * 65 + n], lds[(kc * 8 + 3) * 65 + n]);
          w.z = cvt_pk_bf16(lds[(kc * 8 + 4) * 65 + n], lds[(kc * 8 + 5) * 65 + n]); w.w = cvt_pk_bf16(lds[(kc * 8 + 6) * 65 + n], lds[(kc * 8 + 7) * 65 + n]);
          *(u32x4*)(Wt + (size_t)(n0 + n) * K + k0 + kc * 8) = w; }
        __syncthreads();
    }
}
__device__ __forceinline__ void prep_weights_a(const Params& p, float* lds, int tid, int bid, int nb) {
    unsigned char* ws = p.ws;
    __syncthreads();
    transpose_mat(p.in[17], 1024, 1024, 1024, (bf16_t*)(ws + OFF_EV_OUT), lds, tid, bid, nb);
    transpose_mat(p.in[35], 1024, 4096, 4096, (bf16_t*)(ws + OFF_W1_0), lds, tid, bid, nb);
    transpose_mat(p.in[36], 4096, 1024, 1024, (bf16_t*)(ws + OFF_W2_0), lds, tid, bid, nb);
    transpose_mat(p.in[18], 1024, 4352, 4352, (bf16_t*)(ws + OFF_OD_IN), lds, tid, bid, nb);
}
__device__ __forceinline__ void prep_weights_b(const Params& p, float* lds, int tid, int bid, int nb) {
    unsigned char* ws = p.ws;
    __syncthreads();
    transpose_mat(p.in[32], 1024, 1024, 1024, (bf16_t*)(ws + OFF_OD_OUT), lds, tid, bid, nb);
    transpose_mat(p.in[35] + (size_t)1024 * 4096, 1024, 4096, 4096, (bf16_t*)(ws + OFF_W1_1), lds, tid, bid, nb);
    transpose_mat(p.in[36] + (size_t)1024 * 4096, 4096, 1024, 1024, (bf16_t*)(ws + OFF_W2_1), lds, tid, bid, nb);
}
__device__ __forceinline__ void phase_prep(const Params& p, float* lds, int tid, int bid, int nb) {
    unsigned char* ws = p.ws;
    { const float4* x4 = (const float4*)p.in[0]; uint2* xb = (uint2*)(ws + OFF_XB);
#pragma unroll 2
      for (size_t i = (size_t)bid * 512 + tid; i < (size_t)16384 * 256; i += (size_t)nb * 512) { const float4 v = x4[i]; uint2 o; o.x = cvt_pk_bf16(v.x, v.y); o.y = cvt_pk_bf16(v.z, v.w); xb[i] = o; } }
    transpose_mat(p.in[1], 1024, 3596, 3840, (bf16_t*)(ws + OFF_EV_IN), lds, tid, bid, nb);
    { float* zs = lds; float* ha = lds + 8 * 36; float* hb = ha + 512; float* w1s = hb + 512; float* w2s = w1s + 33 * 64; float* w3s = w2s + 4096; float* H3 = (float*)(ws + OFF_H3);
      const float* b1 = p.in[5]; const float* b2 = p.in[7]; const float* b3 = p.in[9]; const float* fr = p.in[11];
      __syncthreads();
      for (int i = tid; i < 33 * 64; i += 512) w1s[i] = p.in[4][i];
      for (int i = tid; i < 4096; i += 512) { w2s[i] = p.in[6][i]; w3s[i] = p.in[8][i]; }
      const int pl = tid >> 6, j = tid & 63; const float fq = fr[j], bb1 = b1[j], bb2 = b2[j], bb3 = b3[j];
      __syncthreads();
      for (int it = bid; it < 512; it += nb) {
          const int pos = it * 8 + pl;
          if (j < 33) { const float pf = (float)pos; float val;
              if (j == 0) val = pf / 4095.f;
              else { const int bi = (j - 1) & 15; const float band = 1e-4f + (float)bi * ((15.f - 1e-4f) / 15.f); const float ang = band * (6.283185307179586f / 4096.f) * pf; val = (j <= 16) ? cosf(ang) : -sinf(ang); }
              zs[pl * 36 + j] = val; }
          __syncthreads();
          float acc = bb1;
#pragma unroll 11
          for (int i = 0; i < 33; ++i) acc += zs[pl * 36 + i] * w1s[i * 64 + j];
          ha[pl * 64 + j] = sinf(fq * acc);
          __syncthreads();
          acc = bb2;
#pragma unroll 16
          for (int i = 0; i < 64; ++i) acc += ha[pl * 64 + i] * w2s[i * 64 + j];
          hb[pl * 64 + j] = sinf(fq * acc);
          __syncthreads();
          acc = bb3;
#pragma unroll 16
          for (int i = 0; i < 64; ++i) acc += hb[pl * 64 + i] * w3s[i * 64 + j];
          H3[pos * 64 + j] = sinf(fq * acc);
          __syncthreads();
      } }
}

__device__ __forceinline__ void phase_gdn_prep(const Params& p, int tid, int bid, int nb) {
    const int wave = tid >> 6, lane = tid & 63;
    const bf16_t* PG = (const bf16_t*)(p.ws + OFF_PG); bf16_t* QK = (bf16_t*)(p.ws + OFF_QKVP); float* SC = (float*)(p.ws + OFF_SC);
    const float* cw = p.in[13];
    for (int it = bid * 8 + wave; it < 4096 * 4; it += nb * 8) {
        const int tk0 = (it >> 2) * 4, h = it & 3, t0 = tk0 & 4095;
        float acc[4][3][2];
#pragma unroll
        for (int o = 0; o < 4; ++o)
#pragma unroll
            for (int s3 = 0; s3 < 3; ++s3) { acc[o][s3][0] = 0.f; acc[o][s3][1] = 0.f; }
        float2 w[5][3];
#pragma unroll
        for (int j = 0; j < 5; ++j)
#pragma unroll
            for (int s3 = 0; s3 < 3; ++s3) w[j][s3] = *(const float2*)(cw + j * 1536 + s3 * 512 + h * 128 + lane * 2);
#pragma unroll
        for (int r = 0; r < 8; ++r) { const int tt = t0 + r - 2;
            if (tt >= 0 && tt < 4096) { const bf16_t* row = PG + (size_t)(tk0 + r - 2) * 2304 + h * 128 + lane * 2;
#pragma unroll
                for (int s3 = 0; s3 < 3; ++s3) { const unsigned u = *(const unsigned*)(row + s3 * 512); const float u0 = bflo(u), u1 = bfhi(u);
#pragma unroll
                    for (int j = 0; j < 5; ++j) { const int o = r - j; if (o >= 0 && o < 4) { acc[o][s3][0] += w[j][s3].x * u0; acc[o][s3][1] += w[j][s3].y * u1; } } } } }
#pragma unroll
        for (int o = 0; o < 4; ++o) { const int tk = tk0 + o;
#pragma unroll
            for (int s3 = 0; s3 < 3; ++s3) { acc[o][s3][0] = silu(acc[o][s3][0]); acc[o][s3][1] = silu(acc[o][s3][1]); }
            float sq = acc[o][0][0] * acc[o][0][0] + acc[o][0][1] * acc[o][0][1], sk = acc[o][1][0] * acc[o][1][0] + acc[o][1][1] * acc[o][1][1];
#pragma unroll
            for (int sh = 32; sh >= 1; sh >>= 1) { sq += __shfl_xor(sq, sh); sk += __shfl_xor(sk, sh); }
            const float rq = rsqrtf(sq + 1e-6f) * 0.08838834764831845f, rk = rsqrtf(sk + 1e-6f);
            bf16_t* op = QK + (size_t)tk * 1536 + h * 128 + lane * 2;
            *(unsigned*)(op) = cvt_pk_bf16(acc[o][0][0] * rq, acc[o][0][1] * rq);
            *(unsigned*)(op + 512) = cvt_pk_bf16(acc[o][1][0] * rk, acc[o][1][1] * rk);
            *(unsigned*)(op + 1024) = cvt_pk_bf16(acc[o][2][0], acc[o][2][1]);
            if (lane < 3) { const bf16_t* row = PG + (size_t)tk * 2304; float val;
                if (lane == 0) val = sigm(bf1(row[2056 + h]));
                else { const int d = lane - 1; const float a = bf1(row[2048 + d * 4 + h]) + p.in[15][d * 4 + h]; const float sp = a > 20.f ? a : log1pf(expf(a)); val = expf(-expf(p.in[14][d * 4 + h]) * sp); }
                SC[((size_t)tk * 4 + h) * 4 + lane] = val; } }
    }
}

__device__ __forceinline__ float2 cmul(float2 a, float2 b) { return make_float2(a.x * b.x - a.y * b.y, a.x * b.y + a.y * b.x); }
__device__ __forceinline__ float2 cadd(float2 a, float2 b) { return make_float2(a.x + b.x, a.y + b.y); }
__device__ __forceinline__ float2 csub(float2 a, float2 b) { return make_float2(a.x - b.x, a.y - b.y); }
template <bool ZP> __device__ __forceinline__ void fft_fwd(float2* D, int tid) {
    for (int S = 4096; S >= 4; S >>= 2) {
        const int Q = S >> 1; const float inv = -0.5f / (float)S; const bool zp = ZP && S == 4096;
#pragma unroll 2
        for (int i = tid; i < 2048; i += 512) { const int k = i & (Q - 1), j = ((i - k) << 2) + k;
            const float2 x0 = D[j], x1 = D[j + Q]; float2 x2 = make_float2(0.f, 0.f), x3 = x2;
            if (!zp) { x2 = D[j + 2 * Q]; x3 = D[j + 3 * Q]; }
            const float rev = (float)k * inv;
            const float2 w1 = make_float2(__builtin_amdgcn_cosf(rev), __builtin_amdgcn_sinf(rev)), w2 = make_float2(w1.x * w1.x - w1.y * w1.y, 2.f * w1.x * w1.y);
            const float2 a0 = cadd(x0, x2), a2 = cmul(csub(x0, x2), w1), a1 = cadd(x1, x3), t = cmul(csub(x1, x3), w1), a3 = make_float2(t.y, -t.x);
            D[j] = cadd(a0, a1); D[j + Q] = cmul(csub(a0, a1), w2); D[j + 2 * Q] = cadd(a2, a3); D[j + 3 * Q] = cmul(csub(a2, a3), w2); }
        __syncthreads();
    }
#pragma unroll 2
    for (int i = tid; i < 4096; i += 512) { const float2 a = D[2 * i], b = D[2 * i + 1]; D[2 * i] = cadd(a, b); D[2 * i + 1] = csub(a, b); }
    __syncthreads();
}
__device__ __forceinline__ void fft_inv(float2* D, int tid) {
#pragma unroll 2
    for (int i = tid; i < 4096; i += 512) { const float2 a = D[2 * i], b = D[2 * i + 1]; D[2 * i] = cadd(a, b); D[2 * i + 1] = csub(a, b); }
    __syncthreads();
    for (int s = 2; s <= 2048; s <<= 2) {
        const float inv = 0.25f / (float)s; const bool last = s == 2048;
#pragma unroll 2
        for (int i = tid; i < 2048; i += 512) { const int k = i & (s - 1), j = ((i - k) << 2) + k;
            const float2 x0 = D[j], x1 = D[j + s], x2 = D[j + 2 * s], x3 = D[j + 3 * s];
            const float rev = (float)k * inv;
            const float2 v = make_float2(__builtin_amdgcn_cosf(rev), __builtin_amdgcn_sinf(rev)), u1 = make_float2(v.x * v.x - v.y * v.y, 2.f * v.x * v.y);
            float2 t = cmul(x1, u1); const float2 a0 = cadd(x0, t), a1 = csub(x0, t); t = cmul(x3, u1); const float2 a2 = cadd(x2, t), a3 = csub(x2, t);
            t = cmul(a2, v); D[j] = cadd(a0, t); if (!last) D[j + 2 * s] = csub(a0, t);
            t = cmul(a3, v); t = make_float2(-t.y, t.x); D[j + s] = cadd(a1, t); if (!last) D[j + 3 * s] = csub(a1, t); }
        __syncthreads();
    }
}
__device__ __forceinline__ float conv3(const bf16_t* row, int t, float w0, float w1, float w2, float bias) {
    const bf16_t* q = row + t;
    const bf16_t a = q[-1], b = q[0], c = q[1];
    const float um = t > 0 ? bf1(a) : 0.f, u0 = bf1(b), up = t < 4095 ? bf1(c) : 0.f;
    return w0 * um + w1 * u0 + w2 * up + bias; }
__device__ __forceinline__ void hyena_channel(const Params& p, int c, int slot, float* lds, int tid) {
    float2* D = (float2*)lds; float* Z = lds + 16384; float* w4s = lds + 32768;
    float2* HfG = (float2*)((unsigned char*)p.out + DO_HF) + (size_t)slot * 8192;
    const bf16_t* PH = (const bf16_t*)(p.ws + OFF_PH); const float* H3 = (const float*)(p.ws + OFF_H3);
    const float* cw = p.in[2]; const float* cb = p.in[3]; const float* w4 = p.in[10]; const float* skp = p.in[12];
    bf16_t* YA = (bf16_t*)((unsigned char*)p.out + DO_YA);
    __syncthreads();
    { const int ch = 1024 + c; const float w0 = cw[ch], w1 = cw[1536 + ch], w2 = cw[3072 + ch], bb = cb[ch]; const bf16_t* row = PH + (size_t)ch * 16384;
#pragma unroll 2
      for (int idx = tid; idx < 16384; idx += 512) { const int t = idx & 4095; Z[idx] = conv3(row + (idx - t), t, w0, w1, w2, bb); } }
    const float delta = fabsf(-3.0701134573253944f + (float)c * ((-15.350567286626972f + 3.0701134573253944f) / 511.f));
    float* FG1 = (float*)((unsigned char*)p.out + DO_FG1) + (size_t)slot * 8192;
    if (tid < 256) w4s[tid] = w4[(tid & 63) * 2048 + (tid >> 6) * 512 + c];
    __syncthreads();
#pragma unroll 1
    for (int hlf = 0; hlf < 2; ++hlf) { float acc[4][4]; const int tb = tid + 2048 * hlf;
#pragma unroll
      for (int i = 0; i < 4; ++i) { acc[i][0] = 0.f; acc[i][1] = 0.f; acc[i][2] = 0.f; acc[i][3] = 0.f; }
#pragma unroll 1
      for (int jj = 0; jj < 64; jj += 4) {
          float4 hv[4];
#pragma unroll
          for (int i = 0; i < 4; ++i) hv[i] = *(const float4*)(H3 + (tb + 512 * i) * 64 + jj);
#pragma unroll
          for (int q = 0; q < 4; ++q) { const float4 wv = *(const float4*)(w4s + q * 64 + jj);
#pragma unroll
              for (int i = 0; i < 4; ++i) acc[i][q] += (hv[i].x * wv.x + hv[i].y * wv.y) + (hv[i].z * wv.z + hv[i].w * wv.w); } }
#pragma unroll
      for (int i = 0; i < 4; ++i) { const int t = tb + 512 * i; const float win = expf(-((float)t / 4095.f) * delta);
          const float hf0 = acc[i][0] * win, hb0 = acc[i][1] * win, hf1 = acc[i][2] * win, hb1 = acc[i][3] * win;
          if (t == 0) { D[0] = make_float2(hf0 + hb0, 0.f); D[4096] = make_float2(0.f, 0.f); FG1[0] = hf1 + hb1; FG1[4096] = 0.f; }
          else { D[t] = make_float2(hf0, 0.f); D[8192 - t] = make_float2(hb0, 0.f); FG1[t] = hf1; FG1[8192 - t] = hb1; } } }
#pragma unroll 1
    for (int o = 0; o < 2; ++o) {
        __syncthreads();
        if (o == 1) {
#pragma unroll 4
            for (int idx = tid; idx < 8192; idx += 512) D[idx] = make_float2(FG1[idx], 0.f); }
        __syncthreads();
        fft_fwd<false>(D, tid);
#pragma unroll 2
        for (int idx = tid; idx < 8192; idx += 512) HfG[idx] = D[idx];
        const float skip = skp[o * 512 + c];
        const int gch = o * 512 + c; const float g0 = cw[gch], g1 = cw[1536 + gch], g2 = cw[3072 + gch], gb = cb[gch];
#pragma unroll 1
        for (int pr = 0; pr < 2; ++pr) {
            __syncthreads();
#pragma unroll 2
            for (int t = tid; t < 4096; t += 512) D[t] = make_float2(Z[(2 * pr) * 4096 + t], Z[(2 * pr + 1) * 4096 + t]);
            __syncthreads();
            fft_fwd<true>(D, tid);
#pragma unroll 2
            for (int idx = tid; idx < 8192; idx += 512) { const float2 a = D[idx], hh = HfG[idx]; D[idx] = make_float2(a.x * hh.x - a.y * hh.y, a.x * hh.y + a.y * hh.x); }
            __syncthreads();
            fft_inv(D, tid);
            const bf16_t* grow = PH + (size_t)gch * 16384 + (2 * pr) * 4096;
#pragma unroll 2
            for (int t = tid; t < 4096; t += 512) { const float2 y = D[t];
                const float ga = conv3(grow, t, g0, g1, g2, gb), gbv = conv3(grow + 4096, t, g0, g1, g2, gb);
                Z[(2 * pr) * 4096 + t] = ga * (y.x * (1.f / 8192.f) + skip * Z[(2 * pr) * 4096 + t]);
                Z[(2 * pr + 1) * 4096 + t] = gbv * (y.y * (1.f / 8192.f) + skip * Z[(2 * pr + 1) * 4096 + t]); }
        }
    }
    __syncthreads();
#pragma unroll 2
    for (int idx = tid; idx < 16384; idx += 512) YA[(size_t)c * 16384 + idx] = f2bf(Z[idx]);
    __syncthreads();
}

__device__ __forceinline__ void gate_norm_token(bf16_t* mixp, const bf16_t* obp, const bf16_t* gp, const float (&nw8)[8]) {
    const uint4 uf = *(const uint4*)mixp, ub = *(const uint4*)obp, ug = *(const uint4*)gp;
    float v[8], g[8];
    v[0] = bflo(uf.x) + bflo(ub.x); v[1] = bfhi(uf.x) + bfhi(ub.x); v[2] = bflo(uf.y) + bflo(ub.y); v[3] = bfhi(uf.y) + bfhi(ub.y);
    v[4] = bflo(uf.z) + bflo(ub.z); v[5] = bfhi(uf.z) + bfhi(ub.z); v[6] = bflo(uf.w) + bflo(ub.w); v[7] = bfhi(uf.w) + bfhi(ub.w);
    g[0] = bflo(ug.x); g[1] = bfhi(ug.x); g[2] = bflo(ug.y); g[3] = bfhi(ug.y); g[4] = bflo(ug.z); g[5] = bfhi(ug.z); g[6] = bflo(ug.w); g[7] = bfhi(ug.w);
    float ss = 0.f;
#pragma unroll
    for (int i = 0; i < 8; ++i) ss += v[i] * v[i];
    const float r = rsqrtf(rowsum16(ss) * (1.f / 128.f) + 1e-6f);
#pragma unroll
    for (int i = 0; i < 8; ++i) v[i] = v[i] * r * nw8[i] * silu(g[i]);
    uint4 w; w.x = cvt_pk_bf16(v[0], v[1]); w.y = cvt_pk_bf16(v[2], v[3]); w.z = cvt_pk_bf16(v[4], v[5]); w.w = cvt_pk_bf16(v[6], v[7]);
    *(uint4*)mixp = w;
}
__device__ __forceinline__ void phase_post0(const Params& p, float* lds, int tid, int bid, int nb) {
    const int wave = tid >> 6, lane = tid & 63;
    bf16_t* MIX = (bf16_t*)(p.ws + OFF_MIX); const bf16_t* OB = (const bf16_t*)((unsigned char*)p.out + DO_OB); const bf16_t* PG = (const bf16_t*)(p.ws + OFF_PG);
    const float* nw = p.in[16];
    { float nw8[8];
#pragma unroll
      for (int i = 0; i < 8; ++i) nw8[i] = nw[(lane & 15) * 8 + i];
#pragma unroll 2
      for (int tk = bid * 8 + wave; tk < 16384; tk += nb * 8) { const size_t o = (size_t)tk * 1024 + 512 + lane * 8;
          gate_norm_token(MIX + o, OB + o, PG + (size_t)tk * 2304 + 1536 + lane * 8, nw8); } }
    const bf16_t* YA = (const bf16_t*)((unsigned char*)p.out + DO_YA); bf16_t* tl = (bf16_t*)lds;
    for (int tile = bid; tile < 8 * 256; tile += nb) { const int c0 = (tile & 7) * 64, t0 = (tile >> 3) * 64;
        { const int cr = tid >> 3, tc = tid & 7; *(uint4*)(tl + cr * 72 + tc * 8) = *(const uint4*)(YA + (size_t)(c0 + cr) * 16384 + t0 + tc * 8); }
        __syncthreads();
        { const int r = tid >> 3, cc = tid & 7; u32x4 w; unsigned short v[8];
#pragma unroll
          for (int i = 0; i < 8; ++i) v[i] = tl[(cc * 8 + i) * 72 + r];
          w.x = v[0] | ((unsigned)v[1] << 16); w.y = v[2] | ((unsigned)v[3] << 16); w.z = v[4] | ((unsigned)v[5] << 16); w.w = v[6] | ((unsigned)v[7] << 16);
          *(u32x4*)(MIX + (size_t)(t0 + r) * 1024 + c0 + cc * 8) = w; }
        __syncthreads();
    }
}

template <bool FINAL> __device__ __forceinline__ void phase_ln(const float* TMP, const float* g, const float* bt, bf16_t* XB, float* outf, int tid, int bid, int nb) {
    const int wave = tid >> 6, lane = tid & 63;
#pragma unroll 2
    for (int row = bid * 8 + wave; row < 16384; row += nb * 8) {
        float4 v[4]; float sm = 0.f;
#pragma unroll
        for (int i = 0; i < 4; ++i) { v[i] = *(const float4*)(TMP + (size_t)row * 1024 + i * 256 + lane * 4); sm += (v[i].x + v[i].y) + (v[i].z + v[i].w); }
        const float mean = wave_sum(sm) * (1.f / 1024.f); float sq = 0.f;
#pragma unroll
        for (int i = 0; i < 4; ++i) { v[i].x -= mean; v[i].y -= mean; v[i].z -= mean; v[i].w -= mean; sq += (v[i].x * v[i].x + v[i].y * v[i].y) + (v[i].z * v[i].z + v[i].w * v[i].w); }
        const float r = rsqrtf(wave_sum(sq) * (1.f / 1024.f) + 1e-5f);
#pragma unroll
        for (int i = 0; i < 4; ++i) { const int col = i * 256 + lane * 4; const float4 gg = *(const float4*)(g + col), bb = *(const float4*)(bt + col);
            const float y0 = v[i].x * r * gg.x + bb.x, y1 = v[i].y * r * gg.y + bb.y, y2 = v[i].z * r * gg.z + bb.z, y3 = v[i].w * r * gg.w + bb.w;
            if (FINAL) *(float4*)(outf + (size_t)row * 1024 + col) = make_float4(y0, y1, y2, y3);
            else { uint2 o; o.x = cvt_pk_bf16(y0, y1); o.y = cvt_pk_bf16(y2, y3); *(uint2*)(XB + (size_t)row * 1024 + col) = o; } }
    }
}

__device__ __forceinline__ float rw_shift(const bf16_t* P1, const float* mu, int tk, int t, int idx) {
    const bf16_t* q = P1 + (size_t)tk * 4352 + 2560 + idx;
    const float u = bf1(q[0]), pv = t > 0 ? bf1(q[-4352]) : 0.f, nx = t < 4095 ? bf1(q[4352]) : 0.f;
    return u + mu[idx] * (pv - u) + mu[1792 + idx] * (nx - u); }

__device__ __forceinline__ void phase_rw_lora(const Params& p, float* lds, int tid, int bid, int nb) {
    const bf16_t* P1 = (const bf16_t*)(p.ws + OFF_P); const float* mu = p.in[21];
    bf16_t* DW0 = (bf16_t*)((unsigned char*)p.out + DO_DW0); bf16_t* DW1 = (bf16_t*)((unsigned char*)p.out + DO_DW1); bf16_t* AA = (bf16_t*)(p.ws + OFF_AA);
    const float* w2 = p.in[23]; const float* a2 = p.in[25];
    float* tw = lds; float* al = lds + 1024;
    for (int it = bid; it < 1024; it += nb) {
#pragma unroll
        for (int k = 0; k < 2; ++k) { const int idx = tid + 512 * k, tt = idx >> 6, c = idx & 63, tk = it * 16 + tt, t = tk & 4095;
            tw[c * 16 + tt] = tanhf(rw_shift(P1, mu, tk, t, 1536 + c)); al[c * 16 + tt] = rw_shift(P1, mu, tk, t, 1600 + c); }
        __syncthreads();
        float a0[16], a1[16], aa[16];
#pragma unroll
        for (int i = 0; i < 16; ++i) { a0[i] = 0.f; a1[i] = 0.f; aa[i] = 0.f; }
#pragma unroll 2
        for (int r = 0; r < 64; ++r) { const float x0 = w2[r * 512 + tid], x1 = w2[32768 + r * 512 + tid], xa = a2[r * 512 + tid];
#pragma unroll
            for (int i4 = 0; i4 < 4; ++i4) { const float4 tv = *(const float4*)(tw + r * 16 + i4 * 4), av = *(const float4*)(al + r * 16 + i4 * 4);
                a0[i4 * 4 + 0] += tv.x * x0; a0[i4 * 4 + 1] += tv.y * x0; a0[i4 * 4 + 2] += tv.z * x0; a0[i4 * 4 + 3] += tv.w * x0;
                a1[i4 * 4 + 0] += tv.x * x1; a1[i4 * 4 + 1] += tv.y * x1; a1[i4 * 4 + 2] += tv.z * x1; a1[i4 * 4 + 3] += tv.w * x1;
                aa[i4 * 4 + 0] += av.x * xa; aa[i4 * 4 + 1] += av.y * xa; aa[i4 * 4 + 2] += av.z * xa; aa[i4 * 4 + 3] += av.w * xa; } }
#pragma unroll
        for (int i = 0; i < 16; ++i) { const size_t o = (size_t)(it * 16 + i) * 512 + tid; DW0[o] = f2bf(a0[i]); DW1[o] = f2bf(a1[i]); AA[o] = f2bf(aa[i]); }
        __syncthreads();
    }
}

#define SCAN_TOK(sg) (b * 4096 + (dir ? 4095 - (sg) : (sg)))
#define SCAN_FLUSH(tile_, bsel_, colbase_) { const int stp = tid >> 4, pr = tid & 15; const int tk = SCAN_TOK((tile_) * 16 + stp); \
        *(unsigned*)(OUT + (size_t)tk * 1024 + (colbase_) + pr * 2) = cvt_pk_bf16(ot[(((bsel_) * 16 + stp) * 32 + pr * 2) * 8], ot[(((bsel_) * 16 + stp) * 32 + pr * 2 + 1) * 8]); }

__device__ __forceinline__ void gdn_scan(const Params& p, int item, float* lds, int tid) {
    const int dir = item >> 6, b = (item >> 4) & 3, h = (item >> 2) & 3, sl = item & 3;
    float* kq = lds; float* vv = lds + 8448; float* sc = vv + 1024; float* ot = sc + 64;
    const bf16_t* QK = (const bf16_t*)(p.ws + OFF_QKVP); const float* SC = (const float*)(p.ws + OFF_SC);
    bf16_t* OUT = dir ? (bf16_t*)((unsigned char*)p.out + DO_OB) : (bf16_t*)(p.ws + OFF_MIX);
    if (tid >= 256) {
        const int lt = tid - 256, st = lt >> 4, pp = lt & 15;
        uint4 aq, ak, av = make_uint4(0, 0, 0, 0), bq = av, bk = av, bv = av; float4 as = make_float4(0.f, 0.f, 0.f, 0.f), bs = as;
#define GL(tile, q_, k_, v_, s_) { const int tk_ = SCAN_TOK((tile) * 16 + st); const bf16_t* row_ = QK + (size_t)tk_ * 1536 + h * 128; \
            q_ = *(const uint4*)(row_ + pp * 8); k_ = *(const uint4*)(row_ + 512 + pp * 8); \
            if (pp < 4) v_ = *(const uint4*)(row_ + 1024 + sl * 32 + pp * 8); \
            if (pp == 4) s_ = *(const float4*)(SC + ((size_t)tk_ * 4 + h) * 4); }
#define GS(buf, q_, k_, v_, s_) { const int el_ = pp * 8, o_ = ((buf) * 16 + st) * 264 + el_ + ((el_ >> 6) << 2); unpack8(k_, kq + o_); unpack8(q_, kq + o_ + 132); \
            if (pp < 4) unpack8(v_, vv + ((buf) * 16 + st) * 32 + pp * 8); \
            if (pp == 4) { sc[((buf) * 16 + st) * 2] = s_.x; sc[((buf) * 16 + st) * 2 + 1] = dir ? s_.z : s_.y; } }
        GL(0, aq, ak, av, as); GS(0, aq, ak, av, as); GL(1, aq, ak, av, as);
        __syncthreads();
        for (int tile = 0; tile < 256; ++tile) {
            if (tile + 2 < 256) GL(tile + 2, bq, bk, bv, bs);
            if (tile + 1 < 256) GS((tile + 1) & 1, aq, ak, av, as);
            aq = bq; ak = bk; av = bv; as = bs;
            __syncthreads();
        }
#undef GL
#undef GS
    } else {
        __builtin_amdgcn_s_setprio(3);
        const int e = tid >> 3, j = tid & 7;
        f32x2_t s2[8];
#pragma unroll
        for (int i = 0; i < 8; ++i) s2[i] = (f32x2_t){0.f, 0.f};
        __syncthreads();
        for (int tile = 0; tile < 256; ++tile) {
            const int buf = tile & 1;
            if (tile > 0) SCAN_FLUSH(tile - 1, buf ^ 1, 512 + h * 128 + sl * 32);
            float oreg[16];
            f32x2_t kb[2][8], qb[2][8]; float vb[2], bb[2], gb[2];
#define GDN_LDSTEP(step_, sl_) { const float* kp = kq + (buf * 16 + (step_)) * 264 + j * 16 + ((j >> 2) << 2); \
                _Pragma("unroll") for (int i = 0; i < 4; ++i) { const float4 kv = *(const float4*)(kp + 4 * i), qv = *(const float4*)(kp + 132 + 4 * i); \
                    kb[sl_][2 * i] = (f32x2_t){kv.x, kv.y}; kb[sl_][2 * i + 1] = (f32x2_t){kv.z, kv.w}; qb[sl_][2 * i] = (f32x2_t){qv.x, qv.y}; qb[sl_][2 * i + 1] = (f32x2_t){qv.z, qv.w}; } \
                vb[sl_] = vv[(buf * 16 + (step_)) * 32 + e]; bb[sl_] = sc[(buf * 16 + (step_)) * 2]; gb[sl_] = sc[(buf * 16 + (step_)) * 2 + 1]; }
            GDN_LDSTEP(0, 0);
#pragma unroll
            for (int step = 0; step < 16; ++step) {
                const int cs = step & 1;
                if (step < 15) GDN_LDSTEP(step + 1, cs ^ 1);
                asm volatile("" ::: "memory");
                const float ve = vb[cs], beta = bb[cs], g = gb[cs];
                f32x2_t a0 = kb[cs][0] * s2[0], a1 = kb[cs][1] * s2[1];
                a0 = fma2(kb[cs][2], s2[2], a0); a1 = fma2(kb[cs][3], s2[3], a1); a0 = fma2(kb[cs][4], s2[4], a0); a1 = fma2(kb[cs][5], s2[5], a1); a0 = fma2(kb[cs][6], s2[6], a0); a1 = fma2(kb[cs][7], s2[7], a1);
                a0 = a0 + a1;
                const float ks = rowsum8(a0.x + a0.y);
                const float tmp = beta * (ve - g * ks);
                const f32x2_t g2 = (f32x2_t){g, g}, t2 = (f32x2_t){tmp, tmp};
#pragma unroll
                for (int i = 0; i < 8; ++i) s2[i] = fma2(s2[i], g2, kb[cs][i] * t2);
                f32x2_t b0 = qb[cs][0] * s2[0], b1 = qb[cs][1] * s2[1];
                b0 = fma2(qb[cs][2], s2[2], b0); b1 = fma2(qb[cs][3], s2[3], b1); b0 = fma2(qb[cs][4], s2[4], b0); b1 = fma2(qb[cs][5], s2[5], b1); b0 = fma2(qb[cs][6], s2[6], b0); b1 = fma2(qb[cs][7], s2[7], b1);
                b0 = b0 + b1;
                oreg[step] = rowsum8(b0.x + b0.y);
            }
#undef GDN_LDSTEP
#pragma unroll
            for (int step = 0; step < 16; ++step) ot[((buf * 16 + step) * 32 + e) * 8 + j] = oreg[step];
            __syncthreads();
        }
        SCAN_FLUSH(255, 1, 512 + h * 128 + sl * 32);
        __builtin_amdgcn_s_setprio(0);
    }
    __syncthreads();
}

__device__ __forceinline__ void hgrn_scan(const Params& p, int item, float* lds, int tid) {
    const int dir = item >> 6, b = (item >> 4) & 3, h = (item >> 2) & 3, sl = item & 3;
    float* kq = lds; float* vv = lds + 8448; float* ot = vv + 1024;
    const bf16_t* P1 = (const bf16_t*)(p.ws + OFF_P);
    bf16_t* OUT = dir ? (bf16_t*)((unsigned char*)p.out + DO_OB) : (bf16_t*)(p.ws + OFF_MIX);
    if (tid >= 256) {
        const int lt = tid - 256, st = lt >> 4, pp = lt & 15;
        float lb[8];
        { const int cb = h * 128 + pp * 8;
#pragma unroll
          for (int i = 0; i < 8; ++i) lb[i] = sigm(p.in[19][512 + cb + i] - p.in[19][cb + i]); }
        uint4 aq, af, av = make_uint4(0, 0, 0, 0), bq = av, bf_ = av, bv = av;
#define HL(tile, q_, f_, v_) { const int tk_ = SCAN_TOK((tile) * 16 + st); const bf16_t* row_ = P1 + (size_t)tk_ * 4352 + h * 128; \
            q_ = *(const uint4*)(row_ + pp * 8); f_ = *(const uint4*)(row_ + 512 + dir * 512 + pp * 8); \
            if (pp < 4) v_ = *(const uint4*)(row_ + 1536 + sl * 32 + pp * 8); }
#define HS(buf, q_, f_, v_) { float t8[8], u8[8]; \
            t8[0] = bflo(q_.x); t8[1] = bfhi(q_.x); t8[2] = bflo(q_.y); t8[3] = bfhi(q_.y); t8[4] = bflo(q_.z); t8[5] = bfhi(q_.z); t8[6] = bflo(q_.w); t8[7] = bfhi(q_.w); \
            u8[0] = bflo(f_.x); u8[1] = bfhi(f_.x); u8[2] = bflo(f_.y); u8[3] = bfhi(f_.y); u8[4] = bflo(f_.z); u8[5] = bfhi(f_.z); u8[6] = bflo(f_.w); u8[7] = bfhi(f_.w); \
            _Pragma("unroll") for (int i = 0; i < 8; ++i) { t8[i] = silu(t8[i]); u8[i] = lb[i] + (1.f - lb[i]) * sigm(u8[i]); } \
            const int el_ = pp * 8; float* d_ = kq + ((buf) * 16 + st) * 264 + el_ + ((el_ >> 6) << 2); \
            *(float4*)d_ = make_float4(u8[0], u8[1], u8[2], u8[3]); *(float4*)(d_ + 4) = make_float4(u8[4], u8[5], u8[6], u8[7]); \
            *(float4*)(d_ + 132) = make_float4(t8[0], t8[1], t8[2], t8[3]); *(float4*)(d_ + 136) = make_float4(t8[4], t8[5], t8[6], t8[7]); \
            if (pp < 4) unpack8(v_, vv + ((buf) * 16 + st) * 32 + pp * 8); }
        uint4 cq = av, cf = av, cv = av;
        HL(0, aq, af, av); HS(0, aq, af, av); HL(1, aq, af, av); HL(2, bq, bf_, bv);
        __syncthreads();
        for (int tile = 0; tile < 256; ++tile) {
            if (tile + 3 < 256) HL(tile + 3, cq, cf, cv);
            if (tile + 1 < 256) HS((tile + 1) & 1, aq, af, av);
            aq = bq; af = bf_; av = bv; bq = cq; bf_ = cf; bv = cv;
            __syncthreads();
        }
#undef HL
#undef HS
    } else {
        __builtin_amdgcn_s_setprio(3);
        const int e = tid >> 3, j = tid & 7;
        f32x2_t s2[8];
#pragma unroll
        for (int i = 0; i < 8; ++i) s2[i] = (f32x2_t){0.f, 0.f};
        __syncthreads();
        for (int tile = 0; tile < 256; ++tile) {
            const int buf = tile & 1;
            if (tile > 0) SCAN_FLUSH(tile - 1, buf ^ 1, h * 128 + sl * 32);
            float oreg[16];
            f32x2_t fb[3][8], qb[3][8]; float vb[3];
#define HG_LDSTEP(step_, sl_) { const float* kp = kq + (buf * 16 + (step_)) * 264 + j * 16 + ((j >> 2) << 2); \
                _Pragma("unroll") for (int i = 0; i < 4; ++i) { const float4 kv = *(const float4*)(kp + 4 * i), qv = *(const float4*)(kp + 132 + 4 * i); \
                    fb[sl_][2 * i] = (f32x2_t){kv.x, kv.y}; fb[sl_][2 * i + 1] = (f32x2_t){kv.z, kv.w}; qb[sl_][2 * i] = (f32x2_t){qv.x, qv.y}; qb[sl_][2 * i + 1] = (f32x2_t){qv.z, qv.w}; } \
                vb[sl_] = vv[(buf * 16 + (step_)) * 32 + e]; }
            HG_LDSTEP(0, 0); HG_LDSTEP(1, 1);
#pragma unroll
            for (int step = 0; step < 16; ++step) {
                const int cs = step % 3;
                if (step < 14) HG_LDSTEP(step + 2, (step + 2) % 3);
                asm volatile("" ::: "memory");
                const f32x2_t v2 = (f32x2_t){vb[cs], vb[cs]};
#pragma unroll
                for (int i = 0; i < 8; ++i) s2[i] = fma2(fb[cs][i], s2[i] - v2, v2);
                f32x2_t b0 = qb[cs][0] * s2[0], b1 = qb[cs][1] * s2[1];
                b0 = fma2(qb[cs][2], s2[2], b0); b1 = fma2(qb[cs][3], s2[3], b1); b0 = fma2(qb[cs][4], s2[4], b0); b1 = fma2(qb[cs][5], s2[5], b1); b0 = fma2(qb[cs][6], s2[6], b0); b1 = fma2(qb[cs][7], s2[7], b1);
                b0 = b0 + b1;
                oreg[step] = rowsum8(b0.x + b0.y);
            }
#undef HG_LDSTEP
#pragma unroll
            for (int step = 0; step < 16; ++step) ot[((buf * 16 + step) * 32 + e) * 8 + j] = oreg[step];
            __syncthreads();
        }
        SCAN_FLUSH(255, 1, h * 128 + sl * 32);
        __builtin_amdgcn_s_setprio(0);
    }
    __syncthreads();
}

__device__ __forceinline__ void rwkv_scan(const Params& p, int item, float* lds, int tid) {
    const int dir = item >> 6, b = (item >> 4) & 3, hh = (item >> 1) & 7, half = item & 1;
    float* tl = lds;
    float* ot = lds + 2 * 16 * 384;
    const bf16_t* P1 = (const bf16_t*)(p.ws + OFF_P);
    bf16_t* OUT = dir ? (bf16_t*)((unsigned char*)p.out + DO_OB) : (bf16_t*)(p.ws + OFF_MIX);
    if (tid >= 256) {
        const bf16_t* DW = (const bf16_t*)((unsigned char*)p.out + (dir ? DO_DW1 : DO_DW0)); const bf16_t* AA = (const bf16_t*)(p.ws + OFF_AA);
        const int lt = tid - 256, st = lt >> 4, cq = lt & 15, ch = hh * 64 + cq * 4;
        const float* mu = p.in[21];
        float m0[3][4], m1[3][4], a0c[4], w0c[4], kkc[4], kac[4];
#pragma unroll
        for (int q = 0; q < 4; ++q) {
#pragma unroll
            for (int s3 = 0; s3 < 3; ++s3) { m0[s3][q] = mu[s3 * 512 + ch + q]; m1[s3][q] = mu[1792 + s3 * 512 + ch + q]; }
            a0c[q] = p.in[24][ch + q]; w0c[q] = p.in[22][dir * 512 + ch + q]; kkc[q] = p.in[27][ch + q]; kac[q] = p.in[28][ch + q]; }
        uint2 au[3][3], bu[3][3], adw, ada, bdw, bda;
#define RL(tile, u_, dw_, da_) { const int tk_ = SCAN_TOK((tile) * 16 + st), t_ = tk_ & 4095; const bf16_t* row_ = P1 + (size_t)tk_ * 4352 + 2560 + ch; \
            const int po_ = t_ > 0 ? -4352 : 0, no_ = t_ < 4095 ? 4352 : 0; \
            _Pragma("unroll") for (int s3 = 0; s3 < 3; ++s3) { u_[1][s3] = *(const uint2*)(row_ + s3 * 512); u_[0][s3] = *(const uint2*)(row_ + po_ + s3 * 512); u_[2][s3] = *(const uint2*)(row_ + no_ + s3 * 512); \
                if (t_ == 0) u_[0][s3] = make_uint2(0u, 0u); if (t_ == 4095) u_[2][s3] = make_uint2(0u, 0u); } \
            dw_ = *(const uint2*)(DW + (size_t)tk_ * 512 + ch); da_ = *(const uint2*)(AA + (size_t)tk_ * 512 + ch); }
#define RS(buf, u_, dw_, da_) { float us[3][4], pv[4], nx[4], cu[4]; \
            _Pragma("unroll") for (int s3 = 0; s3 < 3; ++s3) { \
                cu[0] = bflo(u_[1][s3].x); cu[1] = bfhi(u_[1][s3].x); cu[2] = bflo(u_[1][s3].y); cu[3] = bfhi(u_[1][s3].y); \
                pv[0] = bflo(u_[0][s3].x); pv[1] = bfhi(u_[0][s3].x); pv[2] = bflo(u_[0][s3].y); pv[3] = bfhi(u_[0][s3].y); \
                nx[0] = bflo(u_[2][s3].x); nx[1] = bfhi(u_[2][s3].x); nx[2] = bflo(u_[2][s3].y); nx[3] = bfhi(u_[2][s3].y); \
                _Pragma("unroll") for (int q = 0; q < 4; ++q) us[s3][q] = cu[q] + m0[s3][q] * (pv[q] - cu[q]) + m1[s3][q] * (nx[q] - cu[q]); } \
            float dwv[4], dav[4], av[4], dc[4], kr[4]; \
            dwv[0] = bflo(dw_.x); dwv[1] = bfhi(dw_.x); dwv[2] = bflo(dw_.y); dwv[3] = bfhi(dw_.y); dav[0] = bflo(da_.x); dav[1] = bfhi(da_.x); dav[2] = bflo(da_.y); dav[3] = bfhi(da_.y); \
            float ss = 0.f; \
            _Pragma("unroll") for (int q = 0; q < 4; ++q) { av[q] = sigm(a0c[q] + dav[q]); dc[q] = __expf(-0.6065306597126334f * sigm(w0c[q] + dwv[q])); kr[q] = us[1][q] * kkc[q]; ss += kr[q] * kr[q]; } \
            ss = rowsum16(ss); const float rn = rsqrtf(ss + 1e-6f); \
            float* d_ = tl + ((buf) * 16 + st) * 384 + cq * 4; \
            *(float4*)(d_) = make_float4(us[0][0], us[0][1], us[0][2], us[0][3]); *(float4*)(d_ + 64) = make_float4(dc[0], dc[1], dc[2], dc[3]); \
            *(float4*)(d_ + 128) = make_float4(us[1][0] * (1.f + (av[0] - 1.f) * kac[0]), us[1][1] * (1.f + (av[1] - 1.f) * kac[1]), us[1][2] * (1.f + (av[2] - 1.f) * kac[2]), us[1][3] * (1.f + (av[3] - 1.f) * kac[3])); \
            *(float4*)(d_ + 192) = make_float4(kr[0] * rn, kr[1] * rn, kr[2] * rn, kr[3] * rn); *(float4*)(d_ + 256) = make_float4(kr[0] * rn * av[0], kr[1] * rn * av[1], kr[2] * rn * av[2], kr[3] * rn * av[3]); \
            *(float4*)(d_ + 320) = make_float4(us[2][0], us[2][1], us[2][2], us[2][3]); }
        RL(0, au, adw, ada); RS(0, au, adw, ada); RL(1, au, adw, ada);
        __syncthreads();
        for (int tile = 0; tile < 256; ++tile) {
            if (tile + 2 < 256) RL(tile + 2, bu, bdw, bda);
            if (tile + 1 < 256) RS((tile + 1) & 1, au, adw, ada);
#pragma unroll
            for (int a = 0; a < 3; ++a)
#pragma unroll
                for (int c = 0; c < 3; ++c) au[a][c] = bu[a][c];
            adw = bdw; ada = bda;
            __syncthreads();
        }
#undef RL
#undef RS
    } else {
        __builtin_amdgcn_s_setprio(3);
        const int e = tid >> 3, j = tid & 7, vrow = half * 32 + e;
        f32x2_t s2[4];
#pragma unroll
        for (int i = 0; i < 4; ++i) s2[i] = (f32x2_t){0.f, 0.f};
        __syncthreads();
        for (int tile = 0; tile < 256; ++tile) {
            const int buf = tile & 1;
            if (tile > 0) SCAN_FLUSH(tile - 1, buf ^ 1, 512 + hh * 64 + half * 32);
            float oreg[16];
            f32x2_t rb[3][4], wb[3][4], kb[3][4], kkb[3][4], kab[3][4]; float vb[3];
#define RW_LDSTEP(step_, sl_) { const float* bp = tl + (buf * 16 + (step_)) * 384 + j * 8; \
                _Pragma("unroll") for (int i = 0; i < 2; ++i) { const float4 rv = *(const float4*)(bp + 4 * i), wv = *(const float4*)(bp + 64 + 4 * i), kv = *(const float4*)(bp + 128 + 4 * i), kkv = *(const float4*)(bp + 192 + 4 * i), kav = *(const float4*)(bp + 256 + 4 * i); \
                    rb[sl_][2 * i] = (f32x2_t){rv.x, rv.y}; rb[sl_][2 * i + 1] = (f32x2_t){rv.z, rv.w}; wb[sl_][2 * i] = (f32x2_t){wv.x, wv.y}; wb[sl_][2 * i + 1] = (f32x2_t){wv.z, wv.w}; \
                    kb[sl_][2 * i] = (f32x2_t){kv.x, kv.y}; kb[sl_][2 * i + 1] = (f32x2_t){kv.z, kv.w}; kkb[sl_][2 * i] = (f32x2_t){kkv.x, kkv.y}; kkb[sl_][2 * i + 1] = (f32x2_t){kkv.z, kkv.w}; \
                    kab[sl_][2 * i] = (f32x2_t){kav.x, kav.y}; kab[sl_][2 * i + 1] = (f32x2_t){kav.z, kav.w}; } \
                vb[sl_] = tl[(buf * 16 + (step_)) * 384 + 320 + vrow]; }
            RW_LDSTEP(0, 0); RW_LDSTEP(1, 1);
#pragma unroll
            for (int step = 0; step < 16; ++step) {
                const int cs = step % 3;
                if (step < 14) RW_LDSTEP(step + 2, (step + 2) % 3);
                asm volatile("" ::: "memory");
                f32x2_t a0 = kkb[cs][0] * s2[0], a1 = kkb[cs][1] * s2[1]; a0 = fma2(kkb[cs][2], s2[2], a0); a1 = fma2(kkb[cs][3], s2[3], a1); a0 = a0 + a1;
                const float sa = rowsum8(a0.x + a0.y);
                const f32x2_t nsa = (f32x2_t){-sa, -sa}, v2 = (f32x2_t){vb[cs], vb[cs]};
#pragma unroll
                for (int i = 0; i < 4; ++i) s2[i] = fma2(v2, kb[cs][i], fma2(nsa, kab[cs][i], s2[i] * wb[cs][i]));
                f32x2_t b0 = rb[cs][0] * s2[0], b1 = rb[cs][1] * s2[1]; b0 = fma2(rb[cs][2], s2[2], b0); b1 = fma2(rb[cs][3], s2[3], b1); b0 = b0 + b1;
                oreg[step] = rowsum8(b0.x + b0.y);
            }
#undef RW_LDSTEP
#pragma unroll
            for (int step = 0; step < 16; ++step) ot[((buf * 16 + step) * 32 + e) * 8 + j] = oreg[step];
            __syncthreads();
        }
        SCAN_FLUSH(255, 1, 512 + hh * 64 + half * 32);
        __builtin_amdgcn_s_setprio(0);
    }
    __syncthreads();
}
#undef SCAN_TOK
#undef SCAN_FLUSH

__device__ __forceinline__ void phase_post1(const Params& p, float* lds, int tid, int bid, int nb) {
    const int wave = tid >> 6, lane = tid & 63;
    bf16_t* MIX = (bf16_t*)(p.ws + OFF_MIX); const bf16_t* OB = (const bf16_t*)((unsigned char*)p.out + DO_OB); const bf16_t* P1 = (const bf16_t*)(p.ws + OFF_P);
    { const float* nw = p.in[20]; float nw8[8];
#pragma unroll
      for (int i = 0; i < 8; ++i) nw8[i] = nw[(lane & 15) * 8 + i];
#pragma unroll 2
      for (int tk = bid * 8 + wave; tk < 16384; tk += nb * 8) { const size_t o = (size_t)tk * 1024 + lane * 8;
          gate_norm_token(MIX + o, OB + o, P1 + (size_t)tk * 4352 + 2048 + lane * 8, nw8); } }
    { const float* mu = p.in[21]; const float* g2 = p.in[26]; const bf16_t* AA = (const bf16_t*)(p.ws + OFF_AA);
      const int ch = tid; float* sg = lds;
      const float a0 = p.in[24][ch], kac = p.in[28][ch], rk = p.in[29][ch], lw = p.in[30][ch], lbv = p.in[31][ch];
      const float m0r = mu[ch], m0k = mu[512 + ch], m0v = mu[1024 + ch], m1r = mu[1792 + ch], m1k = mu[1792 + 512 + ch], m1v = mu[1792 + 1024 + ch];
      for (int it = bid; it < 1024; it += nb) {
#pragma unroll
          for (int k = 0; k < 4; ++k) { const int idx = tid + 512 * k, tt = idx >> 7, r = idx & 127, tk = it * 16 + tt; sg[r * 16 + tt] = sigm(rw_shift(P1, mu, tk, tk & 4095, 1664 + r)); }
          __syncthreads();
          float acc[16];
#pragma unroll
          for (int i = 0; i < 16; ++i) acc[i] = 0.f;
#pragma unroll 4
          for (int r = 0; r < 128; ++r) { const float gv = g2[r * 512 + ch];
#pragma unroll
              for (int i4 = 0; i4 < 4; ++i4) { const float4 sv = *(const float4*)(sg + r * 16 + i4 * 4);
                  acc[i4 * 4 + 0] += sv.x * gv; acc[i4 * 4 + 1] += sv.y * gv; acc[i4 * 4 + 2] += sv.z * gv; acc[i4 * 4 + 3] += sv.w * gv; } }
#pragma unroll
          for (int i = 0; i < 16; ++i) { const int tk = it * 16 + i, t = tk & 4095;
              const bf16_t* q = P1 + (size_t)tk * 4352 + 2560 + ch;
              const bool hp = t > 0, hn = t < 4095; const int po = hp ? -4352 : 0, no = hn ? 4352 : 0;
              const float fr = bf1(q[0]), fk = bf1(q[512]), fv = bf1(q[1024]);
              const float pr_ = bf1(q[po]), pk_ = bf1(q[po + 512]), pv_ = bf1(q[po + 1024]), nr_ = bf1(q[no]), nk_ = bf1(q[no + 512]), nv_ = bf1(q[no + 1024]);
              const float rs = fr + m0r * ((hp ? pr_ : 0.f) - fr) + m1r * ((hn ? nr_ : 0.f) - fr);
              const float ks = fk + m0k * ((hp ? pk_ : 0.f) - fk) + m1k * ((hn ? nk_ : 0.f) - fk);
              const float vs = fv + m0v * ((hp ? pv_ : 0.f) - fv) + m1v * ((hn ? nv_ : 0.f) - fv);
              const float av = sigm(a0 + bf1(AA[(size_t)tk * 512 + ch])); const float kp = ks * (1.f + (av - 1.f) * kac);
              const size_t o = (size_t)tk * 1024 + 512 + ch;
              const float y = bf1(MIX[o]) + bf1(OB[o]);
              float d0 = rs * kp * rk, d1 = y;
#pragma unroll
              for (int sh = 32; sh >= 1; sh >>= 1) { d0 += __shfl_xor(d0, sh); d1 += __shfl_xor(d1, sh); }
              const float yc = y - d1 * (1.f / 64.f); const float var = wave_sum(yc * yc) * (1.f / 64.f);
              const float yn = yc * rsqrtf(var + 64e-5f) * lw + lbv;
              MIX[o] = f2bf((yn + d0 * vs) * acc[i]);
              if ((i & 3) == 3) __builtin_amdgcn_sched_barrier(0); }
          __syncthreads();
      } }
}


__global__ void __launch_bounds__(512, 2) hybrid_fwd(Params p) {
    extern __shared__ __attribute__((aligned(16))) unsigned char shm[];
    cg::grid_group grid = cg::this_grid();
    const int tid = threadIdx.x, bid = blockIdx.x, nb = gridDim.x;
    float* lds = (float*)shm; unsigned char* ws = p.ws;
    bf16_t* XB = (bf16_t*)(ws + OFF_XB); bf16_t* MIX = (bf16_t*)(ws + OFF_MIX); bf16_t* Pb = (bf16_t*)(ws + OFF_P); float* TMPP = (float*)(ws + OFF_P);
    const float* lng = p.in[33]; const float* lnb = p.in[34];

    volatile LAS unsigned* xst = (volatile LAS unsigned*)(shm + 131072 + 1024);
    if (tid < 4) xst[tid] = 0u;
    __syncthreads();
    const XcdBarrier xb = xcd_barrier_post((unsigned*)(ws + OFF_BAR), xst);
    phase_prep(p, lds, tid, bid, nb);
    xcd_barrier(xb);
    { EpiBf<0> e1; e1.O = (bf16_t*)(ws + OFF_PH); e1.ldc = 16384; run_gemm(shm, (const bf16_t*)(ws + OFF_EV_IN), XB, 1536, 16384, 1024, e1, bid);
      EpiBf<0> e2; e2.O = (bf16_t*)(ws + OFF_PG); e2.ldc = 2304; run_gemm(shm, XB, (const bf16_t*)(ws + OFF_EV_IN) + (size_t)1536 * 1024, 16384, 2304, 1024, e2, (bid + (nb >> 1)) % nb); }
    xcd_barrier(xb);
    phase_gdn_prep(p, tid, bid, nb);
    xcd_barrier(xb);
    if (bid < 128) gdn_scan(p, bid, lds, tid);
    else { for (int c = bid - 128; c < 512; c += nb - 128) hyena_channel(p, c, bid - 128, lds, tid);
           prep_weights_a(p, lds, tid, bid - 128, nb - 128); }
    grid.sync();
    phase_post0(p, lds, tid, bid, nb);
    xcd_barrier(xb);
    { EpiRes<false> e; e.C = TMPP; e.res = p.in[0]; run_gemm(shm, MIX, (const bf16_t*)(ws + OFF_EV_OUT), 16384, 1024, 1024, e, bid); }
    xcd_barrier(xb);
    phase_ln<false>(TMPP, lng, lnb, XB, nullptr, tid, bid, nb);
    xcd_barrier(xb);
    { EpiBf<1> e; e.O = Pb; e.ldc = 4096; run_gemm(shm, XB, (const bf16_t*)(ws + OFF_W1_0), 16384, 4096, 1024, e, bid); }
    xcd_barrier(xb);
    { EpiRes<true> e; e.C = p.out; e.res = XB; run_gemm(shm, Pb, (const bf16_t*)(ws + OFF_W2_0), 16384, 1024, 4096, e, bid); }
    xcd_barrier(xb);
    phase_ln<false>(p.out, lng + 1024, lnb + 1024, XB, nullptr, tid, bid, nb);
    xcd_barrier(xb);
    { EpiBf<0> e; e.O = Pb; e.ldc = 4352; run_gemm(shm, XB, (const bf16_t*)(ws + OFF_OD_IN), 16384, 4352, 1024, e, bid); }
    xcd_barrier(xb);
    phase_rw_lora(p, lds, tid, bid, nb);
    xcd_barrier(xb);
    if (bid < 128) { hgrn_scan(p, bid, lds, tid); prep_weights_b(p, lds, tid, bid, 128); }
    else for (int it = bid - 128; it < 128; it += nb - 128) rwkv_scan(p, it, lds, tid);
    xcd_barrier(xb);
    phase_post1(p, lds, tid, bid, nb);
    xcd_barrier(xb);
    { EpiRes<true> e; e.C = TMPP; e.res = XB; run_gemm(shm, MIX, (const bf16_t*)(ws + OFF_OD_OUT), 16384, 1024, 1024, e, bid); }
    xcd_barrier(xb);
    phase_ln<false>(TMPP, lng + 2048, lnb + 2048, XB, nullptr, tid, bid, nb);
    xcd_barrier(xb);
    { EpiBf<1> e; e.O = Pb; e.ldc = 4096; run_gemm(shm, XB, (const bf16_t*)(ws + OFF_W1_1), 16384, 4096, 1024, e, bid); }
    xcd_barrier(xb);
    { EpiRes<true> e; e.C = p.out; e.res = XB; run_gemm(shm, Pb, (const bf16_t*)(ws + OFF_W2_1), 16384, 1024, 4096, e, bid); }
    xcd_barrier(xb);
    phase_ln<true>(p.out, lng + 3072, lnb + 3072, nullptr, p.out, tid, bid, nb);
}

extern "C" void kernel_launch(void* const* d_in, const int* in_sizes, int n_in, void* d_out, int out_size, void* d_ws, size_t ws_size, hipStream_t stream) {
    static int grid_blocks = 0;
    if (!grid_blocks) {
        int dev = 0, cus = 0, per_cu = 0;
        hipGetDevice(&dev);
        hipDeviceGetAttribute(&cus, hipDeviceAttributeMultiprocessorCount, dev);
        hipFuncSetAttribute((const void*)hybrid_fwd, hipFuncAttributeMaxDynamicSharedMemorySize, LDS_BYTES);
        hipOccupancyMaxActiveBlocksPerMultiprocessor(&per_cu, (const void*)hybrid_fwd, 512, LDS_BYTES);
        if (per_cu < 1) { fprintf(stderr, "kernel_launch: occupancy query says %d blocks per CU\n", per_cu); per_cu = 1; }
        grid_blocks = cus * per_cu;
        if (n_in != 37 || ws_size < 254 * MBy) fprintf(stderr, "kernel_launch: unexpected n_in %d / ws_size %zu\n", n_in, ws_size);
    }
    hipMemsetAsync((unsigned char*)d_ws + OFF_BAR, 0, XCD_BAR_WORDS * sizeof(unsigned), stream);
    Params p{};
    for (int i = 0; i < 37; ++i) p.in[i] = (const float*)d_in[i];
    p.out = (float*)d_out; p.ws = (unsigned char*)d_ws;
    void* args[] = {&p};
    hipError_t e = hipLaunchCooperativeKernel((const void*)hybrid_fwd, dim3(grid_blocks), dim3(512), args, LDS_BYTES, stream);
    if (e != hipSuccess) fprintf(stderr, "cooperative launch failed: %s (grid %d)\n", hipGetErrorString(e), grid_blocks);
}
```

```cpp
#include <hip/hip_runtime.h>
#include <hip/hip_cooperative_groups.h>
#include <cstdio>
namespace cg = cooperative_groups;
namespace pg8 {
#define PG8_LAS __attribute__((address_space(3)))
typedef unsigned short bf16_t;
typedef short bf16x8 __attribute__((ext_vector_type(8)));
typedef float f32x4 __attribute__((ext_vector_type(4)));
typedef unsigned u32x4 __attribute__((ext_vector_type(4)));
constexpr int BM = 256, BK = 64, HALF = 128, HTB = HALF * BK * 2  , STAGE_BYTES = 8 * HTB, NXCD = 8, WGM = 8;

__host__ __device__ __forceinline__ int lds_byte(int r, int c) { const int st = (r >> 4) * 2 + (c >> 5), rr = r & 15, cc = c & 31, ob = rr * 64 + cc * 2; return st * 1024 + (ob ^ (((ob >> 9) & 1) << 5)); }
__host__ __device__ __forceinline__ void stage_rc(int b, int& R, int& C) { const int st = b / 1024, sb = b % 1024, swz = sb ^ (((sb >> 9) & 1) << 5); R = (st >> 1) * 16 + swz / 64; C = (st & 1) * 32 + (swz % 64) / 2; }
__host__ __device__ __forceinline__ int perm32(int rho) { const int n = rho >> 4, i = rho & 15; return 8 * (i >> 2) + 4 * n + (i & 3); }

struct Unit { int pm, pn; };
struct Gemm { const bf16_t* A; const bf16_t* Bt; int M, N, K; };

struct StaticOrder {
    int nM, nN, nwg, G, c;
    __host__ __device__ void init(int M, int N, int G_, int c_) { nM = M / BM; nN = N / BM; nwg = nM * nN; G = G_; c = c_; }
    __host__ __device__ bool next(int i, Unit& u) const {
        const long L = (long)i * G + c; if (L >= nwg) return false;
        int wgid = (int)L; { const int q = nwg / NXCD, r = nwg % NXCD, xcd = wgid % NXCD, off = wgid / NXCD; wgid = (xcd < r ? xcd * (q + 1) : r * (q + 1) + (xcd - r) * q) + off; }
        const int nig = WGM * nN, gid = wgid / nig, fm = gid * WGM, gsz = (nM - fm) < WGM ? (nM - fm) : WGM;
        u.pm = fm + ((wgid % nig) % gsz); u.pn = (wgid % nig) / gsz; return true;
    }
    __device__ __forceinline__ void a_ready(const Unit&) const {}
    __device__ __forceinline__ void done(const Unit&) const {}
};
__device__ __forceinline__ unsigned cvt_pk_bf16(float lo, float hi) { unsigned r; asm volatile("v_cvt_pk_bf16_f32 %0, %1, %2" : "=v"(r) : "v"(lo), "v"(hi)); return r; }
template <class Epi, class Sched>
__device__ __forceinline__ void gemm_phase(PG8_LAS unsigned char* lds, const Gemm g, const Sched& S, const Epi& E) {
    const int tid = threadIdx.x, wid = __builtin_amdgcn_readfirstlane(tid >> 6), lane = tid & 63, wr = wid >> 2, wc = wid & 3, fr = lane & 15, fq = lane >> 4;
    const int K = g.K, nt = K / BK;
    unsigned voffA[2], voffB[2];
#pragma unroll
    for (int i = 0; i < 2; ++i) { int R, C; stage_rc(tid * 16 + i * 8192, R, C); const int Rb = Epi::PERM ? ((R & ~31) + perm32(R & 31)) : R;
        voffA[i] = (unsigned)(R * K + C) * 2u; voffB[i] = (unsigned)(Rb * K + C) * 2u; }
    const size_t kstep = (size_t)(BK * 2);
    const size_t hstep = (size_t)HALF * K * 2;
    const size_t tstep = 2 * hstep;
    const unsigned ldsw = (unsigned)wid * 1024u;
    const int aoff = lds_byte(wr * 64 + fr, fq * 8), boff = lds_byte(wc * 32 + fr, fq * 8);
#define PG8_SA(b, h) (((b) * 2 + (h)) * HTB)
#define PG8_SB(b, h) ((4 + (b) * 2 + (h)) * HTB)
#define PG8_STAGE(bufoff, gbase, voff) do { _Pragma("unroll") for (int _i = 0; _i < 2; ++_i) \
        __builtin_amdgcn_global_load_lds((const unsigned*)((const char*)(gbase) + (voff)[_i]), (PG8_LAS unsigned*)(lds + (bufoff) + ldsw + _i * 8192), 16, 0, 0); } while (0)
#define PG8_LDA(dst, b, h) do { _Pragma("unroll") for (int m = 0; m < 4; ++m) _Pragma("unroll") for (int k = 0; k < 2; ++k) dst[m][k] = *(const PG8_LAS bf16x8*)(lds + PG8_SA(b, h) + aoff + m * 2048 + k * 1024); } while (0)
#define PG8_LDB(dst, b, h) do { _Pragma("unroll") for (int n = 0; n < 2; ++n) _Pragma("unroll") for (int k = 0; k < 2; ++k) dst[n][k] = *(const PG8_LAS bf16x8*)(lds + PG8_SB(b, h) + boff + n * 2048 + k * 1024); } while (0)
#define PG8_MMA(ai, bj, At, Bt) do { __builtin_amdgcn_s_setprio(1); _Pragma("unroll") for (int m = 0; m < 4; ++m) _Pragma("unroll") for (int n = 0; n < 2; ++n) _Pragma("unroll") for (int k = 0; k < 2; ++k) \
        acc[ai][bj][m][n] = __builtin_amdgcn_mfma_f32_16x16x32_bf16(Bt[n][k], At[m][k], acc[ai][bj][m][n], 0, 0, 0); __builtin_amdgcn_s_setprio(0); } while (0)
#define PG8_WAIT_V(n) asm volatile("s_waitcnt vmcnt(" #n ")" ::: "memory")
#define PG8_WAIT_L(n) asm volatile("s_waitcnt lgkmcnt(" #n ")" ::: "memory")
#define PG8_BAR __builtin_amdgcn_s_barrier()
#define PG8_SCHED __builtin_amdgcn_sched_barrier(0)
    Unit cur, nxt; int ui = 0;
    if (!S.next(0, cur)) return;
    f32x4 acc[2][2][4][2];
#pragma unroll
    for (int a = 0; a < 2; ++a)
#pragma unroll
        for (int b = 0; b < 2; ++b)
#pragma unroll
            for (int m = 0; m < 4; ++m)
#pragma unroll
                for (int n = 0; n < 2; ++n) acc[a][b][m][n] = (f32x4){0.f, 0.f, 0.f, 0.f};
    bf16x8 At[4][2], B0[2][2], B1[2][2];
    const char* cA = (const char*)g.A + (size_t)cur.pm * tstep; const char* cB = (const char*)g.Bt + (size_t)cur.pn * tstep;
    S.a_ready(cur);
    PG8_STAGE(PG8_SB(0, 0), cB, voffB); PG8_STAGE(PG8_SA(0, 0), cA, voffA); PG8_STAGE(PG8_SB(0, 1), cB + hstep, voffB); PG8_STAGE(PG8_SA(0, 1), cA + hstep, voffA);
    if (wr == 1) PG8_BAR;
    PG8_WAIT_V(4); PG8_BAR;
    PG8_STAGE(PG8_SB(1, 0), cB + kstep, voffB); PG8_STAGE(PG8_SA(1, 0), cA + kstep, voffA); PG8_STAGE(PG8_SB(1, 1), cB + hstep + kstep, voffB);
    PG8_WAIT_V(6); PG8_BAR;
    for (;;) {
        const bool has_next = S.next(ui + 1, nxt);
        const char* nA = has_next ? (const char*)g.A + (size_t)nxt.pm * tstep : cA; const char* nB = has_next ? (const char*)g.Bt + (size_t)nxt.pn * tstep : cB;
        for (int t = 0; t < nt; t += 2) {
            const bool last = (t == nt - 2);
            const char* a1 = cA + (size_t)(t + 1) * kstep;
            const char* a2 = last ? nA : cA + (size_t)(t + 2) * kstep; const char* b2 = last ? nB : cB + (size_t)(t + 2) * kstep;
            const char* a3 = a2 + kstep; const char* b3 = b2 + kstep;
            if (last && has_next) S.a_ready(nxt);
            PG8_LDB(B0, 0, 0); PG8_SCHED; PG8_LDA(At, 0, 0); PG8_STAGE(PG8_SA(1, 1), a1 + hstep, voffA);
            PG8_WAIT_L(8); PG8_BAR; PG8_WAIT_L(0); PG8_MMA(0, 0, At, B0); PG8_BAR; PG8_SCHED;
            PG8_LDB(B1, 0, 1); PG8_STAGE(PG8_SB(0, 0), b2, voffB);
            PG8_BAR; PG8_WAIT_L(0); PG8_MMA(0, 1, At, B1); PG8_BAR;
            PG8_LDA(At, 0, 1); PG8_STAGE(PG8_SA(0, 0), a2, voffA);
            PG8_BAR; PG8_WAIT_L(0); PG8_MMA(1, 0, At, B0); PG8_BAR; PG8_SCHED;
            PG8_STAGE(PG8_SB(0, 1), b2 + hstep, voffB);
            PG8_WAIT_V(6); PG8_BAR; PG8_MMA(1, 1, At, B1); PG8_BAR;
            PG8_LDB(B0, 1, 0); PG8_SCHED; PG8_LDA(At, 1, 0); PG8_STAGE(PG8_SA(0, 1), a2 + hstep, voffA);
            PG8_WAIT_L(8); PG8_BAR; PG8_WAIT_L(0); PG8_MMA(0, 0, At, B0); PG8_BAR; PG8_SCHED;
            PG8_LDB(B1, 1, 1); PG8_STAGE(PG8_SB(1, 0), b3, voffB);
            PG8_BAR; PG8_WAIT_L(0); PG8_MMA(0, 1, At, B1); PG8_BAR;
            PG8_LDA(At, 1, 1); PG8_STAGE(PG8_SA(1, 0), a3, voffA);
            PG8_BAR; PG8_WAIT_L(0); PG8_MMA(1, 0, At, B0); PG8_BAR; PG8_SCHED;
            PG8_STAGE(PG8_SB(1, 1), b3 + hstep, voffB);
            PG8_WAIT_V(6); PG8_BAR; PG8_MMA(1, 1, At, B1); PG8_BAR;
        }
        if constexpr (!Epi::AFTER_DRAIN) { E(acc, cur, wr, wc, fr, fq); S.done(cur); }
        if (!has_next) break;
#pragma unroll
        for (int a = 0; a < 2; ++a)
#pragma unroll
            for (int b = 0; b < 2; ++b)
#pragma unroll
                for (int m = 0; m < 4; ++m)
#pragma unroll
                    for (int n = 0; n < 2; ++n) acc[a][b][m][n] = (f32x4){0.f, 0.f, 0.f, 0.f};
        cur = nxt; cA = nA; cB = nB; ++ui;
    }
    PG8_WAIT_V(0);
    if (wr == 0) PG8_BAR;
    PG8_BAR;
    if constexpr (Epi::AFTER_DRAIN) { E.fused(acc, cur, wr, wc, fr, fq, lds, wid, lane); S.done(cur); }
#undef PG8_SA
#undef PG8_SB
#undef PG8_STAGE
#undef PG8_LDA
#undef PG8_LDB
#undef PG8_MMA
#undef PG8_WAIT_V
#undef PG8_WAIT_L
#undef PG8_BAR
#undef PG8_SCHED
}
}
#define XB_TMO      128
#define XB_XCNT(j)  (256  + 64 * (j))
#define XB_XSUB(j)  (1280 + 64 * (j))
#define XB_XGEN(j)  (2304 + 64 * (j))
#define XB_TOP      3328
#define XB_TOPGEN   3392
#define XCD_BAR_WORDS 3456
#define XB_SPIN_CAP (1u << 18)
#define LAS __attribute__((address_space(3)))

__device__ __forceinline__ unsigned xb_ld(unsigned* p)              { return __hip_atomic_load(p, __ATOMIC_RELAXED, __HIP_MEMORY_SCOPE_AGENT); }
__device__ __forceinline__ unsigned xb_add(unsigned* p, unsigned v) { return __hip_atomic_fetch_add(p, v, __ATOMIC_RELAXED, __HIP_MEMORY_SCOPE_AGENT); }
__device__ __forceinline__ unsigned xb_xcc_id() { return (unsigned)__builtin_amdgcn_s_getreg((3 << 11) | 20) & 0xFu; }
#define XB_SPIN(cond, bar) do { unsigned _sp = 0; while (cond) { __builtin_amdgcn_s_sleep(1); \
    if ((++_sp & 255u) == 0u) { if (xb_ld(&(bar)[XB_TMO])) break; if (_sp > XB_SPIN_CAP) { atomicAdd(&(bar)[XB_TMO], 1u); break; } } } } while (0)

struct XcdBarrier {
    unsigned* bar; unsigned x;
    volatile LAS unsigned* st;
};

__device__ __forceinline__ XcdBarrier xcd_barrier_post(unsigned* bar, volatile LAS unsigned* st) {
    XcdBarrier b; b.bar = bar; b.x = xb_xcc_id(); b.st = st;
    if (threadIdx.x == 0) (void)xb_add(&bar[XB_XCNT(b.x)], 1u);
    return b;
}
__device__ __forceinline__ void xcd_barrier_complete(unsigned* bar, unsigned x, unsigned& nloc, unsigned& nx) {
    const unsigned G = gridDim.x * gridDim.y * gridDim.z;
    unsigned sum, cnt, mine, sp = 0u;
    for (;;) {
        sum = 0u; cnt = 0u; mine = 0u;
#pragma unroll
        for (unsigned j = 0; j < 16; ++j) { const unsigned c = xb_ld(&bar[XB_XCNT(j)]); sum += c; cnt += (c > 0u) ? 1u : 0u; mine = (j == x) ? c : mine; }
        if (sum == G) break;
        __builtin_amdgcn_s_sleep(1);
        if ((++sp & 255u) == 0u) { if (xb_ld(&bar[XB_TMO])) break; if (sp > XB_SPIN_CAP) { atomicAdd(&bar[XB_TMO], 1u); break; } }
    }
    nloc = mine > 0u ? mine : 1u; nx = cnt > 0u ? cnt : 1u;
}

__device__ __forceinline__ void xcd_barrier(const XcdBarrier& b) {
    asm volatile("s_waitcnt vmcnt(0)" ::: "memory");
    __syncthreads();
    if (threadIdx.x == 0) {
        unsigned* bar = b.bar;
        __builtin_amdgcn_s_waitcnt(0);
        unsigned nloc = b.st[0], nx = b.st[1];
        if (nloc == 0u) { xcd_barrier_complete(bar, b.x, nloc, nx); b.st[0] = nloc; b.st[1] = nx; }
        const unsigned old = xb_add(&bar[XB_XSUB(b.x)], 1u);
        const unsigned gen = old / nloc;
        if (old + 1u == (gen + 1u) * nloc) {
            __builtin_amdgcn_fence(__ATOMIC_RELEASE, "agent");
            asm volatile("s_waitcnt vmcnt(0)" ::: "memory");
            const unsigned og = xb_add(&bar[XB_TOP], 1u);
            const unsigned tg = og / nx;
            if (og + 1u == (tg + 1u) * nx) xb_add(&bar[XB_TOPGEN], 1u);
            else XB_SPIN(xb_ld(&bar[XB_TOPGEN]) == tg, bar);
            __builtin_amdgcn_fence(__ATOMIC_ACQUIRE, "agent");
            xb_add(&bar[XB_XGEN(b.x)], 1u);
            asm volatile("s_waitcnt vmcnt(0)" ::: "memory");
        } else {
            XB_SPIN(xb_ld(&bar[XB_XGEN(b.x)]) == gen, bar);
            __builtin_amdgcn_fence(__ATOMIC_ACQUIRE, "agent");
            asm volatile("s_waitcnt vmcnt(0)" ::: "memory");
        }
    }
    __syncthreads();
}

using pg8::bf16_t; using pg8::f32x4; using pg8::u32x4; using pg8::cvt_pk_bf16;

constexpr size_t MBy = 1048576;
constexpr size_t OFF_OD_IN = 0, OFF_OD_OUT = OFF_OD_IN + 4352ull * 1024 * 2, OFF_W1_1 = OFF_OD_OUT + 2097152ull, OFF_W2_1 = OFF_W1_1 + 8388608ull;
constexpr size_t OFF_WT0 = OFF_W2_1 + 8388608ull;
constexpr size_t OFF_EV_IN = OFF_WT0, OFF_EV_OUT = OFF_EV_IN + 3840ull * 1024 * 2, OFF_W1_0 = OFF_EV_OUT + 2097152ull, OFF_W2_0 = OFF_W1_0 + 8388608ull;
static_assert(OFF_W2_0 + 8388608ull == 52 * MBy, "weights region");
constexpr size_t OFF_P = 52 * MBy, OFF_XB = 188 * MBy, OFF_MIX = 220 * MBy, OFF_H3 = 252 * MBy, OFF_SC = 253 * MBy;
constexpr size_t OFF_PH = OFF_P, OFF_PG = OFF_P + 48 * MBy, OFF_QKVP = OFF_P + 120 * MBy;
constexpr size_t OFF_AA = OFF_WT0;
constexpr size_t DO_OB = 0, DO_YA = 32 * MBy, DO_HF = 48 * MBy, DO_FG1 = 56 * MBy, DO_DW0 = 32 * MBy, DO_DW1 = 48 * MBy;
constexpr int LDS_BYTES = 131072 + 1024 + 16;
constexpr size_t OFF_BAR = 255 * MBy;
constexpr float ALPHA = 1.41421356237f;

struct Params { const float* in[37]; float* out; unsigned char* ws; };

__device__ __forceinline__ float bflo(unsigned u) { return __uint_as_float(u << 16); }
__device__ __forceinline__ float bfhi(unsigned u) { return __uint_as_float(u & 0xffff0000u); }
__device__ __forceinline__ float bf1(bf16_t b) { return __uint_as_float(((unsigned)b) << 16); }
__device__ __forceinline__ bf16_t f2bf(float f) { return (bf16_t)(cvt_pk_bf16(f, 0.f) & 0xffffu); }
__device__ __forceinline__ float sigm(float x) { return 1.f / (1.f + __expf(-x)); }
__device__ __forceinline__ float silu(float x) { return x / (1.f + __expf(-x)); }
__device__ __forceinline__ float wave_sum(float x) {
#pragma unroll
    for (int o = 32; o >= 1; o >>= 1) x += __shfl_xor(x, o);
    return x; }
#define DPP_ADD_ROR(x, ctl) x += __int_as_float(__builtin_amdgcn_update_dpp(0, __float_as_int(x), ctl, 0xf, 0xf, false))
__device__ __forceinline__ float rowsum16(float x) {
    DPP_ADD_ROR(x, 0x128); DPP_ADD_ROR(x, 0x124); DPP_ADD_ROR(x, 0x122); DPP_ADD_ROR(x, 0x121); return x; }
__device__ __forceinline__ float rowsum8(float x) {
    DPP_ADD_ROR(x, 0x141); DPP_ADD_ROR(x, 0xB1); DPP_ADD_ROR(x, 0x4E); return x; }
typedef float f32x2_t __attribute__((ext_vector_type(2)));
__device__ __forceinline__ f32x2_t fma2(f32x2_t a, f32x2_t b, f32x2_t c) { return __builtin_elementwise_fma(a, b, c); }
__device__ __forceinline__ void unpack8(uint4 r, float* d) {
    *(float4*)d = make_float4(bflo(r.x), bfhi(r.x), bflo(r.y), bfhi(r.y));
    *(float4*)(d + 4) = make_float4(bflo(r.z), bfhi(r.z), bflo(r.w), bfhi(r.w)); }

template <int ACT> struct EpiBf {
    static constexpr bool PERM = true, AFTER_DRAIN = false;
    bf16_t* O; int ldc;
    __device__ __forceinline__ void operator()(const f32x4 (&acc)[2][2][4][2], const pg8::Unit& u, int wr, int wc, int fr, int fq) const {
        const int row0 = u.pm * 256 + wr * 64 + fr, col0 = u.pn * 256 + wc * 32 + 8 * fq;
#pragma unroll
        for (int ai = 0; ai < 2; ++ai)
#pragma unroll
            for (int m = 0; m < 4; ++m) { bf16_t* rowp = O + (size_t)(row0 + ai * 128 + m * 16) * ldc + col0;
#pragma unroll
                for (int bj = 0; bj < 2; ++bj) { f32x4 v0 = acc[ai][bj][m][0], v1 = acc[ai][bj][m][1];
                    if (ACT == 1) {
#pragma unroll
                        for (int j = 0; j < 4; ++j) { float a = fmaxf(v0[j], 0.f), b = fmaxf(v1[j], 0.f); v0[j] = a * a; v1[j] = b * b; } }
                    u32x4 w; w.x = cvt_pk_bf16(v0[0], v0[1]); w.y = cvt_pk_bf16(v0[2], v0[3]); w.z = cvt_pk_bf16(v1[0], v1[1]); w.w = cvt_pk_bf16(v1[2], v1[3]);
                    *(u32x4*)(rowp + bj * 128) = w; } }
    }
};
template <bool RESBF> struct EpiRes {
    static constexpr bool PERM = false, AFTER_DRAIN = false;
    float* C; const void* res;
    __device__ __forceinline__ void operator()(const f32x4 (&acc)[2][2][4][2], const pg8::Unit& u, int wr, int wc, int fr, int fq) const {
        const int row0 = u.pm * 256 + wr * 64 + fr, col0 = u.pn * 256 + wc * 32 + 4 * fq;
#pragma unroll
        for (int ai = 0; ai < 2; ++ai)
#pragma unroll
            for (int m = 0; m < 4; ++m) { const size_t ro = (size_t)(row0 + ai * 128 + m * 16) * 1024 + col0;
#pragma unroll
                for (int bj = 0; bj < 2; ++bj)
#pragma unroll
                    for (int n = 0; n < 2; ++n) { const size_t o = ro + bj * 128 + n * 16; f32x4 r;
                        if (RESBF) { const uint2 w = *(const uint2*)((const bf16_t*)res + o); r = (f32x4){bflo(w.x), bfhi(w.x), bflo(w.y), bfhi(w.y)}; }
                        else r = *(const f32x4*)((const float*)res + o);
                        *(f32x4*)(C + o) = acc[ai][bj][m][n] + r * ALPHA; } }
    }
};
template <class Epi> __device__ __forceinline__ void run_gemm(unsigned char* shm, const bf16_t* A, const bf16_t* Bt, int M, int N, int K, const Epi& E, int c) {
    pg8::Gemm g; g.A = A; g.Bt = Bt; g.M = M; g.N = N; g.K = K;
    pg8::StaticOrder S; S.init(M, N, (int)gridDim.x, c);
    pg8::gemm_phase<Epi, pg8::StaticOrder>((PG8_LAS unsigned char*)shm, g, S, E);
    __syncthreads();
}

__device__ __forceinline__ void transpose_mat(const float* __restrict__ W, int K, int N, int Npad, bf16_t* __restrict__ Wt, float* lds, int tid, int bid, int nb) {
    const int ntk = K >> 6, ntiles = (Npad >> 6) * ntk;
    for (int tile = bid; tile < ntiles; tile += nb) {
        const int tn = tile / ntk, tk = tile - tn * ntk, n0 = tn << 6, k0 = tk << 6;
        { const int c4 = tid & 15, r = tid >> 4;
#pragma unroll
          for (int rr = 0; rr < 2; ++rr) { const int row = r + rr * 32, n = n0 + c4 * 4; float4 v = make_float4(0.f, 0.f, 0.f, 0.f);
              if (n < N) v = *(const float4*)(W + (size_t)(k0 + row) * N + n);
              float* d = lds + row * 65 + c4 * 4; d[0] = v.x; d[1] = v.y; d[2] = v.z; d[3] = v.w; } }
        __syncthreads();
        { const int n = tid >> 3, kc = tid & 7; u32x4 w;
          w.x = cvt_pk_bf16(lds[(kc * 8 + 0) * 65 + n], lds[(kc * 8 + 1) * 65 + n]); w.y = cvt_pk_bf16(lds[(kc * 8 + 2) * 65 + n], lds[(kc * 8 + 3) * 65 + n]);
          w.z = cvt_pk_bf16(lds[(kc * 8 + 4) * 65 + n], lds[(kc * 8 + 5) * 65 + n]); w.w = cvt_pk_bf16(lds[(kc * 8 + 6) * 65 + n], lds[(kc * 8 + 7) * 65 + n]);
          *(u32x4*)(Wt + (size_t)(n0 + n) * K + k0 + kc * 8) = w; }
        __syncthreads();
    }
}
__device__ __forceinline__ void prep_weights_a(const Params& p, float* lds, int tid, int bid, int nb) {
    unsigned char* ws = p.ws;
    __syncthreads();
    transpose_mat(p.in[17], 1024, 1024, 1024, (bf16_t*)(ws + OFF_EV_OUT), lds, tid, bid, nb);
    transpose_mat(p.in[35], 1024, 4096, 4096, (bf16_t*)(ws + OFF_W1_0), lds, tid, bid, nb);
    transpose_mat(p.in[36], 4096, 1024, 1024, (bf16_t*)(ws + OFF_W2_0), lds, tid, bid, nb);
    transpose_mat(p.in[18], 1024, 4352, 4352, (bf16_t*)(ws + OFF_OD_IN), lds, tid, bid, nb);
}
__device__ __forceinline__ void prep_weights_b(const Params& p, float* lds, int tid, int bid, int nb) {
    unsigned char* ws = p.ws;
    __syncthreads();
    transpose_mat(p.in[32], 1024, 1024, 1024, (bf16_t*)(ws + OFF_OD_OUT), lds, tid, bid, nb);
    transpose_mat(p.in[35] + (size_t)1024 * 4096, 1024, 4096, 4096, (bf16_t*)(ws + OFF_W1_1), lds, tid, bid, nb);
    transpose_mat(p.in[36] + (size_t)1024 * 4096, 4096, 1024, 1024, (bf16_t*)(ws + OFF_W2_1), lds, tid, bid, nb);
}
__device__ __forceinline__ void phase_prep(const Params& p, float* lds, int tid, int bid, int nb) {
    unsigned char* ws = p.ws;
    { const float4* x4 = (const float4*)p.in[0]; uint2* xb = (uint2*)(ws + OFF_XB);
#pragma unroll 2
      for (size_t i = (size_t)bid * 512 + tid; i < (size_t)16384 * 256; i += (size_t)nb * 512) { const float4 v = x4[i]; uint2 o; o.x = cvt_pk_bf16(v.x, v.y); o.y = cvt_pk_bf16(v.z, v.w); xb[i] = o; } }
    transpose_mat(p.in[1], 1024, 3596, 3840, (bf16_t*)(ws + OFF_EV_IN), lds, tid, bid, nb);
    { float* zs = lds; float* ha = lds + 8 * 36; float* hb = ha + 512; float* w1s = hb + 512; float* w2s = w1s + 33 * 64; float* w3s = w2s + 4096; float* H3 = (float*)(ws + OFF_H3);
      const float* b1 = p.in[5]; const float* b2 = p.in[7]; const float* b3 = p.in[9]; const float* fr = p.in[11];
      __syncthreads();
      for (int i = tid; i < 33 * 64; i += 512) w1s[i] = p.in[4][i];
      for (int i = tid; i < 4096; i += 512) { w2s[i] = p.in[6][i]; w3s[i] = p.in[8][i]; }
      const int pl = tid >> 6, j = tid & 63; const float fq = fr[j], bb1 = b1[j], bb2 = b2[j], bb3 = b3[j];
      __syncthreads();
      for (int it = bid; it < 512; it += nb) {
          const int pos = it * 8 + pl;
          if (j < 33) { const float pf = (float)pos; float val;
              if (j == 0) val = pf / 4095.f;
              else { const int bi = (j - 1) & 15; const float band = 1e-4f + (float)bi * ((15.f - 1e-4f) / 15.f); const float ang = band * (6.283185307179586f / 4096.f) * pf; val = (j <= 16) ? cosf(ang) : -sinf(ang); }
              zs[pl * 36 + j] = val; }
          __syncthreads();
          float acc = bb1;
#pragma unroll 11
          for (int i = 0; i < 33; ++i) acc += zs[pl * 36 + i] * w1s[i * 64 + j];
          ha[pl * 64 + j] = sinf(fq * acc);
          __syncthreads();
          acc = bb2;
#pragma unroll 16
          for (int i = 0; i < 64; ++i) acc += ha[pl * 64 + i] * w2s[i * 64 + j];
          hb[pl * 64 + j] = sinf(fq * acc);
          __syncthreads();
          acc = bb3;
#pragma unroll 16
          for (int i = 0; i < 64; ++i) acc += hb[pl * 64 + i] * w3s[i * 64 + j];
          H3[pos * 64 + j] = sinf(fq * acc);
          __syncthreads();
      } }
}

__device__ __forceinline__ void phase_gdn_prep(const Params& p, int tid, int bid, int nb) {
    const int wave = tid >> 6, lane = tid & 63;
    const bf16_t* PG = (const bf16_t*)(p.ws + OFF_PG); bf16_t* QK = (bf16_t*)(p.ws + OFF_QKVP); float* SC = (float*)(p.ws + OFF_SC);
    const float* cw = p.in[13];
    for (int it = bid * 8 + wave; it < 4096 * 4; it += nb * 8) {
        const int tk0 = (it >> 2) * 4, h = it & 3, t0 = tk0 & 4095;
        float acc[4][3][2];
#pragma unroll
        for (int o = 0; o < 4; ++o)
#pragma unroll
            for (int s3 = 0; s3 < 3; ++s3) { acc[o][s3][0] = 0.f; acc[o][s3][1] = 0.f; }
        float2 w[5][3];
#pragma unroll
        for (int j = 0; j < 5; ++j)
#pragma unroll
            for (int s3 = 0; s3 < 3; ++s3) w[j][s3] = *(const float2*)(cw + j * 1536 + s3 * 512 + h * 128 + lane * 2);
#pragma unroll
        for (int r = 0; r < 8; ++r) { const int tt = t0 + r - 2;
            if (tt >= 0 && tt < 4096) { const bf16_t* row = PG + (size_t)(tk0 + r - 2) * 2304 + h * 128 + lane * 2;
#pragma unroll
                for (int s3 = 0; s3 < 3; ++s3) { const unsigned u = *(const unsigned*)(row + s3 * 512); const float u0 = bflo(u), u1 = bfhi(u);
#pragma unroll
                    for (int j = 0; j < 5; ++j) { const int o = r - j; if (o >= 0 && o < 4) { acc[o][s3][0] += w[j][s3].x * u0; acc[o][s3][1] += w[j][s3].y * u1; } } } } }
#pragma unroll
        for (int o = 0; o < 4; ++o) { const int tk = tk0 + o;
#pragma unroll
            for (int s3 = 0; s3 < 3; ++s3) { acc[o][s3][0] = silu(acc[o][s3][0]); acc[o][s3][1] = silu(acc[o][s3][1]); }
            float sq = acc[o][0][0] * acc[o][0][0] + acc[o][0][1] * acc[o][0][1], sk = acc[o][1][0] * acc[o][1][0] + acc[o][1][1] * acc[o][1][1];
#pragma unroll
            for (int sh = 32; sh >= 1; sh >>= 1) { sq += __shfl_xor(sq, sh); sk += __shfl_xor(sk, sh); }
            const float rq = rsqrtf(sq + 1e-6f) * 0.08838834764831845f, rk = rsqrtf(sk + 1e-6f);
            bf16_t* op = QK + (size_t)tk * 1536 + h * 128 + lane * 2;
            *(unsigned*)(op) = cvt_pk_bf16(acc[o][0][0] * rq, acc[o][0][1] * rq);
            *(unsigned*)(op + 512) = cvt_pk_bf16(acc[o][1][0] * rk, acc[o][1][1] * rk);
            *(unsigned*)(op + 1024) = cvt_pk_bf16(acc[o][2][0], acc[o][2][1]);
            if (lane < 3) { const bf16_t* row = PG + (size_t)tk * 2304; float val;
                if (lane == 0) val = sigm(bf1(row[2056 + h]));
                else { const int d = lane - 1; const float a = bf1(row[2048 + d * 4 + h]) + p.in[15][d * 4 + h]; const float sp = a > 20.f ? a : log1pf(expf(a)); val = expf(-expf(p.in[14][d * 4 + h]) * sp); }
                SC[((size_t)tk * 4 + h) * 4 + lane] = val; } }
    }
}

__device__ __forceinline__ float2 cmul(float2 a, float2 b) { return make_float2(a.x * b.x - a.y * b.y, a.x * b.y + a.y * b.x); }
__device__ __forceinline__ float2 cadd(float2 a, float2 b) { return make_float2(a.x + b.x, a.y + b.y); }
__device__ __forceinline__ float2 csub(float2 a, float2 b) { return make_float2(a.x - b.x, a.y - b.y); }
template <bool ZP> __device__ __forceinline__ void fft_fwd(float2* D, int tid) {
    for (int S = 4096; S >= 4; S >>= 2) {
        const int Q = S >> 1; const float inv = -0.5f / (float)S; const bool zp = ZP && S == 4096;
#pragma unroll 2
        for (int i = tid; i < 2048; i += 512) { const int k = i & (Q - 1), j = ((i - k) << 2) + k;
            const float2 x0 = D[j], x1 = D[j + Q]; float2 x2 = make_float2(0.f, 0.f), x3 = x2;
            if (!zp) { x2 = D[j + 2 * Q]; x3 = D[j + 3 * Q]; }
            const float rev = (float)k * inv;
            const float2 w1 = make_float2(__builtin_amdgcn_cosf(rev), __builtin_amdgcn_sinf(rev)), w2 = make_float2(w1.x * w1.x - w1.y * w1.y, 2.f * w1.x * w1.y);
            const float2 a0 = cadd(x0, x2), a2 = cmul(csub(x0, x2), w1), a1 = cadd(x1, x3), t = cmul(csub(x1, x3), w1), a3 = make_float2(t.y, -t.x);
            D[j] = cadd(a0, a1); D[j + Q] = cmul(csub(a0, a1), w2); D[j + 2 * Q] = cadd(a2, a3); D[j + 3 * Q] = cmul(csub(a2, a3), w2); }
        __syncthreads();
    }
#pragma unroll 2
    for (int i = tid; i < 4096; i += 512) { const float2 a = D[2 * i], b = D[2 * i + 1]; D[2 * i] = cadd(a, b); D[2 * i + 1] = csub(a, b); }
    __syncthreads();
}
__device__ __forceinline__ void fft_inv(float2* D, int tid) {
#pragma unroll 2
    for (int i = tid; i < 4096; i += 512) { const float2 a = D[2 * i], b = D[2 * i + 1]; D[2 * i] = cadd(a, b); D[2 * i + 1] = csub(a, b); }
    __syncthreads();
    for (int s = 2; s <= 2048; s <<= 2) {
        const float inv = 0.25f / (float)s; const bool last = s == 2048;
#pragma unroll 2
        for (int i = tid; i < 2048; i += 512) { const int k = i & (s - 1), j = ((i - k) << 2) + k;
            const float2 x0 = D[j], x1 = D[j + s], x2 = D[j + 2 * s], x3 = D[j + 3 * s];
            const float rev = (float)k * inv;
            const float2 v = make_float2(__builtin_amdgcn_cosf(rev), __builtin_amdgcn_sinf(rev)), u1 = make_float2(v.x * v.x - v.y * v.y, 2.f * v.x * v.y);
            float2 t = cmul(x1, u1); const float2 a0 = cadd(x0, t), a1 = csub(x0, t); t = cmul(x3, u1); const float2 a2 = cadd(x2, t), a3 = csub(x2, t);
            t = cmul(a2, v); D[j] = cadd(a0, t); if (!last) D[j + 2 * s] = csub(a0, t);
            t = cmul(a3, v); t = make_float2(-t.y, t.x); D[j + s] = cadd(a1, t); if (!last) D[j + 3 * s] = csub(a1, t); }
        __syncthreads();
    }
}
__device__ __forceinline__ float conv3(const bf16_t* row, int t, float w0, float w1, float w2, float bias) {
    const bf16_t* q = row + t;
    const bf16_t a = q[-1], b = q[0], c = q[1];
    const float um = t > 0 ? bf1(a) : 0.f, u0 = bf1(b), up = t < 4095 ? bf1(c) : 0.f;
    return w0 * um + w1 * u0 + w2 * up + bias; }
__device__ __forceinline__ void hyena_channel(const Params& p, int c, int slot, float* lds, int tid) {
    float2* D = (float2*)lds; float* Z = lds + 16384; float* w4s = lds + 32768;
    float2* HfG = (float2*)((unsigned char*)p.out + DO_HF) + (size_t)slot * 8192;
    const bf16_t* PH = (const bf16_t*)(p.ws + OFF_PH); const float* H3 = (const float*)(p.ws + OFF_H3);
    const float* cw = p.in[2]; const float* cb = p.in[3]; const float* w4 = p.in[10]; const float* skp = p.in[12];
    bf16_t* YA = (bf16_t*)((unsigned char*)p.out + DO_YA);
    __syncthreads();
    { const int ch = 1024 + c; const float w0 = cw[ch], w1 = cw[1536 + ch], w2 = cw[3072 + ch], bb = cb[ch]; const bf16_t* row = PH + (size_t)ch * 16384;
#pragma unroll 2
      for (int idx = tid; idx < 16384; idx += 512) { const int t = idx & 4095; Z[idx] = conv3(row + (idx - t), t, w0, w1, w2, bb); } }
    const float delta = fabsf(-3.0701134573253944f + (float)c * ((-15.350567286626972f + 3.0701134573253944f) / 511.f));
    float* FG1 = (float*)((unsigned char*)p.out + DO_FG1) + (size_t)slot * 8192;
    if (tid < 256) w4s[tid] = w4[(tid & 63) * 2048 + (tid >> 6) * 512 + c];
    __syncthreads();
#pragma unroll 1
    for (int hlf = 0; hlf < 2; ++hlf) { float acc[4][4]; const int tb = tid + 2048 * hlf;
#pragma unroll
      for (int i = 0; i < 4; ++i) { acc[i][0] = 0.f; acc[i][1] = 0.f; acc[i][2] = 0.f; acc[i][3] = 0.f; }
#pragma unroll 1
      for (int jj = 0; jj < 64; jj += 4) {
          float4 hv[4];
#pragma unroll
          for (int i = 0; i < 4; ++i) hv[i] = *(const float4*)(H3 + (tb + 512 * i) * 64 + jj);
#pragma unroll
          for (int q = 0; q < 4; ++q) { const float4 wv = *(const float4*)(w4s + q * 64 + jj);
#pragma unroll
              for (int i = 0; i < 4; ++i) acc[i][q] += (hv[i].x * wv.x + hv[i].y * wv.y) + (hv[i].z * wv.z + hv[i].w * wv.w); } }
#pragma unroll
      for (int i = 0; i < 4; ++i) { const int t = tb + 512 * i; const float win = expf(-((float)t / 4095.f) * delta);
          const float hf0 = acc[i][0] * win, hb0 = acc[i][1] * win, hf1 = acc[i][2] * win, hb1 = acc[i][3] * win;
          if (t == 0) { D[0] = make_float2(hf0 + hb0, 0.f); D[4096] = make_float2(0.f, 0.f); FG1[0] = hf1 + hb1; FG1[4096] = 0.f; }
          else { D[t] = make_float2(hf0, 0.f); D[8192 - t] = make_float2(hb0, 0.f); FG1[t] = hf1; FG1[8192 - t] = hb1; } } }
#pragma unroll 1
    for (int o = 0; o < 2; ++o) {
        __syncthreads();
        if (o == 1) {
#pragma unroll 4
            for (int idx = tid; idx < 8192; idx += 512) D[idx] = make_float2(FG1[idx], 0.f); }
        __syncthreads();
        fft_fwd<false>(D, tid);
#pragma unroll 2
        for (int idx = tid; idx < 8192; idx += 512) HfG[idx] = D[idx];
        const float skip = skp[o * 512 + c];
        const int gch = o * 512 + c; const float g0 = cw[gch], g1 = cw[1536 + gch], g2 = cw[3072 + gch], gb = cb[gch];
#pragma unroll 1
        for (int pr = 0; pr < 2; ++pr) {
            __syncthreads();
#pragma unroll 2
            for (int t = tid; t < 4096; t += 512) D[t] = make_float2(Z[(2 * pr) * 4096 + t], Z[(2 * pr + 1) * 4096 + t]);
            __syncthreads();
            fft_fwd<true>(D, tid);
#pragma unroll 2
            for (int idx = tid; idx < 8192; idx += 512) { const float2 a = D[idx], hh = HfG[idx]; D[idx] = make_float2(a.x * hh.x - a.y * hh.y, a.x * hh.y + a.y * hh.x); }
            __syncthreads();
            fft_inv(D, tid);
            const bf16_t* grow = PH + (size_t)gch * 16384 + (2 * pr) * 4096;
#pragma unroll 2
            for (int t = tid; t < 4096; t += 512) { const float2 y = D[t];
                const float ga = conv3(grow, t, g0, g1, g2, gb), gbv = conv3(grow + 4096, t, g0, g1, g2, gb);
                Z[(2 * pr) * 4096 + t] = ga * (y.x * (1.f / 8192.f) + skip * Z[(2 * pr) * 4096 + t]);
                Z[(2 * pr + 1) * 4096 + t] = gbv * (y.y * (1.f / 8192.f) + skip * Z[(2 * pr + 1) * 4096 + t]); }
        }
    }
    __syncthreads();
#pragma unroll 2
    for (int idx = tid; idx < 16384; idx += 512) YA[(size_t)c * 16384 + idx] = f2bf(Z[idx]);
    __syncthreads();
}

__device__ __forceinline__ void gate_norm_token(bf16_t* mixp, const bf16_t* obp, const bf16_t* gp, const float (&nw8)[8]) {
    const uint4 uf = *(const uint4*)mixp, ub = *(const uint4*)obp, ug = *(const uint4*)gp;
    float v[8], g[8];
    v[0] = bflo(uf.x) + bflo(ub.x); v[1] = bfhi(uf.x) + bfhi(ub.x); v[2] = bflo(uf.y) + bflo(ub.y); v[3] = bfhi(uf.y) + bfhi(ub.y);
    v[4] = bflo(uf.z) + bflo(ub.z); v[5] = bfhi(uf.z) + bfhi(ub.z); v[6] = bflo(uf.w) + bflo(ub.w); v[7] = bfhi(uf.w) + bfhi(ub.w);
    g[0] = bflo(ug.x); g[1] = bfhi(ug.x); g[2] = bflo(ug.y); g[3] = bfhi(ug.y); g[4] = bflo(ug.z); g[5] = bfhi(ug.z); g[6] = bflo(ug.w); g[7] = bfhi(ug.w);
    float ss = 0.f;
#pragma unroll
    for (int i = 0; i < 8; ++i) ss += v[i] * v[i];
    const float r = rsqrtf(rowsum16(ss) * (1.f / 128.f) + 1e-6f);
#pragma unroll
    for (int i = 0; i < 8; ++i) v[i] = v[i] * r * nw8[i] * silu(g[i]);
    uint4 w; w.x = cvt_pk_bf16(v[0], v[1]); w.y = cvt_pk_bf16(v[2], v[3]); w.z = cvt_pk_bf16(v[4], v[5]); w.w = cvt_pk_bf16(v[6], v[7]);
    *(uint4*)mixp = w;
}
__device__ __forceinline__ void phase_post0(const Params& p, float* lds, int tid, int bid, int nb) {
    const int wave = tid >> 6, lane = tid & 63;
    bf16_t* MIX = (bf16_t*)(p.ws + OFF_MIX); const bf16_t* OB = (const bf16_t*)((unsigned char*)p.out + DO_OB); const bf16_t* PG = (const bf16_t*)(p.ws + OFF_PG);
    const float* nw = p.in[16];
    { float nw8[8];
#pragma unroll
      for (int i = 0; i < 8; ++i) nw8[i] = nw[(lane & 15) * 8 + i];
#pragma unroll 2
      for (int tk = bid * 8 + wave; tk < 16384; tk += nb * 8) { const size_t o = (size_t)tk * 1024 + 512 + lane * 8;
          gate_norm_token(MIX + o, OB + o, PG + (size_t)tk * 2304 + 1536 + lane * 8, nw8); } }
    const bf16_t* YA = (const bf16_t*)((unsigned char*)p.out + DO_YA); bf16_t* tl = (bf16_t*)lds;
    for (int tile = bid; tile < 8 * 256; tile += nb) { const int c0 = (tile & 7) * 64, t0 = (tile >> 3) * 64;
        { const int cr = tid >> 3, tc = tid & 7; *(uint4*)(tl + cr * 72 + tc * 8) = *(const uint4*)(YA + (size_t)(c0 + cr) * 16384 + t0 + tc * 8); }
        __syncthreads();
        { const int r = tid >> 3, cc = tid & 7; u32x4 w; unsigned short v[8];
#pragma unroll
          for (int i = 0; i < 8; ++i) v[i] = tl[(cc * 8 + i) * 72 + r];
          w.x = v[0] | ((unsigned)v[1] << 16); w.y = v[2] | ((unsigned)v[3] << 16); w.z = v[4] | ((unsigned)v[5] << 16); w.w = v[6] | ((unsigned)v[7] << 16);
          *(u32x4*)(MIX + (size_t)(t0 + r) * 1024 + c0 + cc * 8) = w; }
        __syncthreads();
    }
}

template <bool FINAL> __device__ __forceinline__ void phase_ln(const float* TMP, const float* g, const float* bt, bf16_t* XB, float* outf, int tid, int bid, int nb) {
    const int wave = tid >> 6, lane = tid & 63;
#pragma unroll 2
    for (int row = bid * 8 + wave; row < 16384; row += nb * 8) {
        float4 v[4]; float sm = 0.f;
#pragma unroll
        for (int i = 0; i < 4; ++i) { v[i] = *(const float4*)(TMP + (size_t)row * 1024 + i * 256 + lane * 4); sm += (v[i].x + v[i].y) + (v[i].z + v[i].w); }
        const float mean = wave_sum(sm) * (1.f / 1024.f); float sq = 0.f;
#pragma unroll
        for (int i = 0; i < 4; ++i) { v[i].x -= mean; v[i].y -= mean; v[i].z -= mean; v[i].w -= mean; sq += (v[i].x * v[i].x + v[i].y * v[i].y) + (v[i].z * v[i].z + v[i].w * v[i].w); }
        const float r = rsqrtf(wave_sum(sq) * (1.f / 1024.f) + 1e-5f);
#pragma unroll
        for (int i = 0; i < 4; ++i) { const int col = i * 256 + lane * 4; const float4 gg = *(const float4*)(g + col), bb = *(const float4*)(bt + col);
            const float y0 = v[i].x * r * gg.x + bb.x, y1 = v[i].y * r * gg.y + bb.y, y2 = v[i].z * r * gg.z + bb.z, y3 = v[i].w * r * gg.w + bb.w;
            if (FINAL) *(float4*)(outf + (size_t)row * 1024 + col) = make_float4(y0, y1, y2, y3);
            else { uint2 o; o.x = cvt_pk_bf16(y0, y1); o.y = cvt_pk_bf16(y2, y3); *(uint2*)(XB + (size_t)row * 1024 + col) = o; } }
    }
}

__device__ __forceinline__ float rw_shift(const bf16_t* P1, const float* mu, int tk, int t, int idx) {
    const bf16_t* q = P1 + (size_t)tk * 4352 + 2560 + idx;
    const float u = bf1(q[0]), pv = t > 0 ? bf1(q[-4352]) : 0.f, nx = t < 4095 ? bf1(q[4352]) : 0.f;
    return u + mu[idx] * (pv - u) + mu[1792 + idx] * (nx - u); }

__device__ __forceinline__ void phase_rw_lora(const Params& p, float* lds, int tid, int bid, int nb) {
    const bf16_t* P1 = (const bf16_t*)(p.ws + OFF_P); const float* mu = p.in[21];
    bf16_t* DW0 = (bf16_t*)((unsigned char*)p.out + DO_DW0); bf16_t* DW1 = (bf16_t*)((unsigned char*)p.out + DO_DW1); bf16_t* AA = (bf16_t*)(p.ws + OFF_AA);
    const float* w2 = p.in[23]; const float* a2 = p.in[25];
    float* tw = lds; float* al = lds + 1024;
    for (int it = bid; it < 1024; it += nb) {
#pragma unroll
        for (int k = 0; k < 2; ++k) { const int idx = tid + 512 * k, tt = idx >> 6, c = idx & 63, tk = it * 16 + tt, t = tk & 4095;
            tw[c * 16 + tt] = tanhf(rw_shift(P1, mu, tk, t, 1536 + c)); al[c * 16 + tt] = rw_shift(P1, mu, tk, t, 1600 + c); }
        __syncthreads();
        float a0[16], a1[16], aa[16];
#pragma unroll
        for (int i = 0; i < 16; ++i) { a0[i] = 0.f; a1[i] = 0.f; aa[i] = 0.f; }
#pragma unroll 2
        for (int r = 0; r < 64; ++r) { const float x0 = w2[r * 512 + tid], x1 = w2[32768 + r * 512 + tid], xa = a2[r * 512 + tid];
#pragma unroll
            for (int i4 = 0; i4 < 4; ++i4) { const float4 tv = *(const float4*)(tw + r * 16 + i4 * 4), av = *(const float4*)(al + r * 16 + i4 * 4);
                a0[i4 * 4 + 0] += tv.x * x0; a0[i4 * 4 + 1] += tv.y * x0; a0[i4 * 4 + 2] += tv.z * x0; a0[i4 * 4 + 3] += tv.w * x0;
                a1[i4 * 4 + 0] += tv.x * x1; a1[i4 * 4 + 1] += tv.y * x1; a1[i4 * 4 + 2] += tv.z * x1; a1[i4 * 4 + 3] += tv.w * x1;
                aa[i4 * 4 + 0] += av.x * xa; aa[i4 * 4 + 1] += av.y * xa; aa[i4 * 4 + 2] += av.z * xa; aa[i4 * 4 + 3] += av.w * xa; } }
#pragma unroll
        for (int i = 0; i < 16; ++i) { const size_t o = (size_t)(it * 16 + i) * 512 + tid; DW0[o] = f2bf(a0[i]); DW1[o] = f2bf(a1[i]); AA[o] = f2bf(aa[i]); }
        __syncthreads();
    }
}

#define SCAN_TOK(sg) (b * 4096 + (dir ? 4095 - (sg) : (sg)))
#define SCAN_FLUSH(tile_, bsel_, colbase_) { const int stp = tid >> 4, pr = tid & 15; const int tk = SCAN_TOK((tile_) * 16 + stp); \
        *(unsigned*)(OUT + (size_t)tk * 1024 + (colbase_) + pr * 2) = cvt_pk_bf16(ot[(((bsel_) * 16 + stp) * 32 + pr * 2) * 8], ot[(((bsel_) * 16 + stp) * 32 + pr * 2 + 1) * 8]); }

__device__ __forceinline__ void gdn_scan(const Params& p, int item, float* lds, int tid) {
    const int dir = item >> 6, b = (item >> 4) & 3, h = (item >> 2) & 3, sl = item & 3;
    float* kq = lds; float* vv = lds + 8448; float* sc = vv + 1024; float* ot = sc + 64;
    const bf16_t* QK = (const bf16_t*)(p.ws + OFF_QKVP); const float* SC = (const float*)(p.ws + OFF_SC);
    bf16_t* OUT = dir ? (bf16_t*)((unsigned char*)p.out + DO_OB) : (bf16_t*)(p.ws + OFF_MIX);
    if (tid >= 256) {
        const int lt = tid - 256, st = lt >> 4, pp = lt & 15;
        uint4 aq, ak, av = make_uint4(0, 0, 0, 0), bq = av, bk = av, bv = av; float4 as = make_float4(0.f, 0.f, 0.f, 0.f), bs = as;
#define GL(tile, q_, k_, v_, s_) { const int tk_ = SCAN_TOK((tile) * 16 + st); const bf16_t* row_ = QK + (size_t)tk_ * 1536 + h * 128; \
            q_ = *(const uint4*)(row_ + pp * 8); k_ = *(const uint4*)(row_ + 512 + pp * 8); \
            if (pp < 4) v_ = *(const uint4*)(row_ + 1024 + sl * 32 + pp * 8); \
            if (pp == 4) s_ = *(const float4*)(SC + ((size_t)tk_ * 4 + h) * 4); }
#define GS(buf, q_, k_, v_, s_) { const int el_ = pp * 8, o_ = ((buf) * 16 + st) * 264 + el_ + ((el_ >> 6) << 2); unpack8(k_, kq + o_); unpack8(q_, kq + o_ + 132); \
            if (pp < 4) unpack8(v_, vv + ((buf) * 16 + st) * 32 + pp * 8); \
            if (pp == 4) { sc[((buf) * 16 + st) * 2] = s_.x; sc[((buf) * 16 + st) * 2 + 1] = dir ? s_.z : s_.y; } }
        GL(0, aq, ak, av, as); GS(0, aq, ak, av, as); GL(1, aq, ak, av, as);
        __syncthreads();
        for (int tile = 0; tile < 256; ++tile) {
            if (tile + 2 < 256) GL(tile + 2, bq, bk, bv, bs);
            if (tile + 1 < 256) GS((tile + 1) & 1, aq, ak, av, as);
            aq = bq; ak = bk; av = bv; as = bs;
            __syncthreads();
        }
#undef GL
#undef GS
    } else {
        __builtin_amdgcn_s_setprio(3);
        const int e = tid >> 3, j = tid & 7;
        f32x2_t s2[8];
#pragma unroll
        for (int i = 0; i < 8; ++i) s2[i] = (f32x2_t){0.f, 0.f};
        __syncthreads();
        for (int tile = 0; tile < 256; ++tile) {
            const int buf = tile & 1;
            if (tile > 0) SCAN_FLUSH(tile - 1, buf ^ 1, 512 + h * 128 + sl * 32);
            float oreg[16];
            f32x2_t kb[2][8], qb[2][8]; float vb[2], bb[2], gb[2];
#define GDN_LDSTEP(step_, sl_) { const float* kp = kq + (buf * 16 + (step_)) * 264 + j * 16 + ((j >> 2) << 2); \
                _Pragma("unroll") for (int i = 0; i < 4; ++i) { const float4 kv = *(const float4*)(kp + 4 * i), qv = *(const float4*)(kp + 132 + 4 * i); \
                    kb[sl_][2 * i] = (f32x2_t){kv.x, kv.y}; kb[sl_][2 * i + 1] = (f32x2_t){kv.z, kv.w}; qb[sl_][2 * i] = (f32x2_t){qv.x, qv.y}; qb[sl_][2 * i + 1] = (f32x2_t){qv.z, qv.w}; } \
                vb[sl_] = vv[(buf * 16 + (step_)) * 32 + e]; bb[sl_] = sc[(buf * 16 + (step_)) * 2]; gb[sl_] = sc[(buf * 16 + (step_)) * 2 + 1]; }
            GDN_LDSTEP(0, 0);
#pragma unroll
            for (int step = 0; step < 16; ++step) {
                const int cs = step & 1;
                if (step < 15) GDN_LDSTEP(step + 1, cs ^ 1);
                asm volatile("" ::: "memory");
                const float ve = vb[cs], beta = bb[cs], g = gb[cs];
                f32x2_t a0 = kb[cs][0] * s2[0], a1 = kb[cs][1] * s2[1];
                a0 = fma2(kb[cs][2], s2[2], a0); a1 = fma2(kb[cs][3], s2[3], a1); a0 = fma2(kb[cs][4], s2[4], a0); a1 = fma2(kb[cs][5], s2[5], a1); a0 = fma2(kb[cs][6], s2[6], a0); a1 = fma2(kb[cs][7], s2[7], a1);
                a0 = a0 + a1;
                const float ks = rowsum8(a0.x + a0.y);
                const float tmp = beta * (ve - g * ks);
                const f32x2_t g2 = (f32x2_t){g, g}, t2 = (f32x2_t){tmp, tmp};
#pragma unroll
                for (int i = 0; i < 8; ++i) s2[i] = fma2(s2[i], g2, kb[cs][i] * t2);
                f32x2_t b0 = qb[cs][0] * s2[0], b1 = qb[cs][1] * s2[1];
                b0 = fma2(qb[cs][2], s2[2], b0); b1 = fma2(qb[cs][3], s2[3], b1); b0 = fma2(qb[cs][4], s2[4], b0); b1 = fma2(qb[cs][5], s2[5], b1); b0 = fma2(qb[cs][6], s2[6], b0); b1 = fma2(qb[cs][7], s2[7], b1);
                b0 = b0 + b1;
                oreg[step] = rowsum8(b0.x + b0.y);
            }
#undef GDN_LDSTEP
#pragma unroll
            for (int step = 0; step < 16; ++step) ot[((buf * 16 + step) * 32 + e) * 8 + j] = oreg[step];
            __syncthreads();
        }
        SCAN_FLUSH(255, 1, 512 + h * 128 + sl * 32);
        __builtin_amdgcn_s_setprio(0);
    }
    __syncthreads();
}

__device__ __forceinline__ void hgrn_scan(const Params& p, int item, float* lds, int tid) {
    const int dir = item >> 6, b = (item >> 4) & 3, h = (item >> 2) & 3, sl = item & 3;
    float* kq = lds; float* vv = lds + 8448; float* ot = vv + 1024;
    const bf16_t* P1 = (const bf16_t*)(p.ws + OFF_P);
    bf16_t* OUT = dir ? (bf16_t*)((unsigned char*)p.out + DO_OB) : (bf16_t*)(p.ws + OFF_MIX);
    if (tid >= 256) {
        const int lt = tid - 256, st = lt >> 4, pp = lt & 15;
        float lb[8];
        { const int cb = h * 128 + pp * 8;
#pragma unroll
          for (int i = 0; i < 8; ++i) lb[i] = sigm(p.in[19][512 + cb + i] - p.in[19][cb + i]); }
        uint4 aq, af, av = make_uint4(0, 0, 0, 0), bq = av, bf_ = av, bv = av;
#define HL(tile, q_, f_, v_) { const int tk_ = SCAN_TOK((tile) * 16 + st); const bf16_t* row_ = P1 + (size_t)tk_ * 4352 + h * 128; \
            q_ = *(const uint4*)(row_ + pp * 8); f_ = *(const uint4*)(row_ + 512 + dir * 512 + pp * 8); \
            if (pp < 4) v_ = *(const uint4*)(row_ + 1536 + sl * 32 + pp * 8); }
#define HS(buf, q_, f_, v_) { float t8[8], u8[8]; \
            t8[0] = bflo(q_.x); t8[1] = bfhi(q_.x); t8[2] = bflo(q_.y); t8[3] = bfhi(q_.y); t8[4] = bflo(q_.z); t8[5] = bfhi(q_.z); t8[6] = bflo(q_.w); t8[7] = bfhi(q_.w); \
            u8[0] = bflo(f_.x); u8[1] = bfhi(f_.x); u8[2] = bflo(f_.y); u8[3] = bfhi(f_.y); u8[4] = bflo(f_.z); u8[5] = bfhi(f_.z); u8[6] = bflo(f_.w); u8[7] = bfhi(f_.w); \
            _Pragma("unroll") for (int i = 0; i < 8; ++i) { t8[i] = silu(t8[i]); u8[i] = lb[i] + (1.f - lb[i]) * sigm(u8[i]); } \
            const int el_ = pp * 8; float* d_ = kq + ((buf) * 16 + st) * 264 + el_ + ((el_ >> 6) << 2); \
            *(float4*)d_ = make_float4(u8[0], u8[1], u8[2], u8[3]); *(float4*)(d_ + 4) = make_float4(u8[4], u8[5], u8[6], u8[7]); \
            *(float4*)(d_ + 132) = make_float4(t8[0], t8[1], t8[2], t8[3]); *(float4*)(d_ + 136) = make_float4(t8[4], t8[5], t8[6], t8[7]); \
            if (pp < 4) unpack8(v_, vv + ((buf) * 16 + st) * 32 + pp * 8); }
        uint4 cq = av, cf = av, cv = av;
        HL(0, aq, af, av); HS(0, aq, af, av); HL(1, aq, af, av); HL(2, bq, bf_, bv);
        __syncthreads();
        for (int tile = 0; tile < 256; ++tile) {
            if (tile + 3 < 256) HL(tile + 3, cq, cf, cv);
            if (tile + 1 < 256) HS((tile + 1) & 1, aq, af, av);
            aq = bq; af = bf_; av = bv; bq = cq; bf_ = cf; bv = cv;
            __syncthreads();
        }
#undef HL
#undef HS
    } else {
        __builtin_amdgcn_s_setprio(3);
        const int e = tid >> 3, j = tid & 7;
        f32x2_t s2[8];
#pragma unroll
        for (int i = 0; i < 8; ++i) s2[i] = (f32x2_t){0.f, 0.f};
        __syncthreads();
        for (int tile = 0; tile < 256; ++tile) {
            const int buf = tile & 1;
            if (tile > 0) SCAN_FLUSH(tile - 1, buf ^ 1, h * 128 + sl * 32);
            float oreg[16];
            f32x2_t fb[3][8], qb[3][8]; float vb[3];
#define HG_LDSTEP(step_, sl_) { const float* kp = kq + (buf * 16 + (step_)) * 264 + j * 16 + ((j >> 2) << 2); \
                _Pragma("unroll") for (int i = 0; i < 4; ++i) { const float4 kv = *(const float4*)(kp + 4 * i), qv = *(const float4*)(kp + 132 + 4 * i); \
                    fb[sl_][2 * i] = (f32x2_t){kv.x, kv.y}; fb[sl_][2 * i + 1] = (f32x2_t){kv.z, kv.w}; qb[sl_][2 * i] = (f32x2_t){qv.x, qv.y}; qb[sl_][2 * i + 1] = (f32x2_t){qv.z, qv.w}; } \
                vb[sl_] = vv[(buf * 16 + (step_)) * 32 + e]; }
            HG_LDSTEP(0, 0); HG_LDSTEP(1, 1);
#pragma unroll
            for (int step = 0; step < 16; ++step) {
                const int cs = step % 3;
                if (step < 14) HG_LDSTEP(step + 2, (step + 2) % 3);
                asm volatile("" ::: "memory");
                const f32x2_t v2 = (f32x2_t){vb[cs], vb[cs]};
#pragma unroll
                for (int i = 0; i < 8; ++i) s2[i] = fma2(fb[cs][i], s2[i] - v2, v2);
                f32x2_t b0 = qb[cs][0] * s2[0], b1 = qb[cs][1] * s2[1];
                b0 = fma2(qb[cs][2], s2[2], b0); b1 = fma2(qb[cs][3], s2[3], b1); b0 = fma2(qb[cs][4], s2[4], b0); b1 = fma2(qb[cs][5], s2[5], b1); b0 = fma2(qb[cs][6], s2[6], b0); b1 = fma2(qb[cs][7], s2[7], b1);
                b0 = b0 + b1;
                oreg[step] = rowsum8(b0.x + b0.y);
            }
#undef HG_LDSTEP
#pragma unroll
            for (int step = 0; step < 16; ++step) ot[((buf * 16 + step) * 32 + e) * 8 + j] = oreg[step];
            __syncthreads();
        }
        SCAN_FLUSH(255, 1, h * 128 + sl * 32);
        __builtin_amdgcn_s_setprio(0);
    }
    __syncthreads();
}

__device__ __forceinline__ void rwkv_scan(const Params& p, int item, float* lds, int tid) {
    const int dir = item >> 6, b = (item >> 4) & 3, hh = (item >> 1) & 7, half = item & 1;
    float* tl = lds;
    float* ot = lds + 2 * 16 * 384;
    const bf16_t* P1 = (const bf16_t*)(p.ws + OFF_P);
    bf16_t* OUT = dir ? (bf16_t*)((unsigned char*)p.out + DO_OB) : (bf16_t*)(p.ws + OFF_MIX);
    if (tid >= 256) {
        const bf16_t* DW = (const bf16_t*)((unsigned char*)p.out + (dir ? DO_DW1 : DO_DW0)); const bf16_t* AA = (const bf16_t*)(p.ws + OFF_AA);
        const int lt = tid - 256, st = lt >> 4, cq = lt & 15, ch = hh * 64 + cq * 4;
        const float* mu = p.in[21];
        float m0[3][4], m1[3][4], a0c[4], w0c[4], kkc[4], kac[4];
#pragma unroll
        for (int q = 0; q < 4; ++q) {
#pragma unroll
            for (int s3 = 0; s3 < 3; ++s3) { m0[s3][q] = mu[s3 * 512 + ch + q]; m1[s3][q] = mu[1792 + s3 * 512 + ch + q]; }
            a0c[q] = p.in[24][ch + q]; w0c[q] = p.in[22][dir * 512 + ch + q]; kkc[q] = p.in[27][ch + q]; kac[q] = p.in[28][ch + q]; }
        uint2 au[3][3], bu[3][3], adw, ada, bdw, bda;
#define RL(tile, u_, dw_, da_) { const int tk_ = SCAN_TOK((tile) * 16 + st), t_ = tk_ & 4095; const bf16_t* row_ = P1 + (size_t)tk_ * 4352 + 2560 + ch; \
            const int po_ = t_ > 0 ? -4352 : 0, no_ = t_ < 4095 ? 4352 : 0; \
            _Pragma("unroll") for (int s3 = 0; s3 < 3; ++s3) { u_[1][s3] = *(const uint2*)(row_ + s3 * 512); u_[0][s3] = *(const uint2*)(row_ + po_ + s3 * 512); u_[2][s3] = *(const uint2*)(row_ + no_ + s3 * 512); \
                if (t_ == 0) u_[0][s3] = make_uint2(0u, 0u); if (t_ == 4095) u_[2][s3] = make_uint2(0u, 0u); } \
            dw_ = *(const uint2*)(DW + (size_t)tk_ * 512 + ch); da_ = *(const uint2*)(AA + (size_t)tk_ * 512 + ch); }
#define RS(buf, u_, dw_, da_) { float us[3][4], pv[4], nx[4], cu[4]; \
            _Pragma("unroll") for (int s3 = 0; s3 < 3; ++s3) { \
                cu[0] = bflo(u_[1][s3].x); cu[1] = bfhi(u_[1][s3].x); cu[2] = bflo(u_[1][s3].y); cu[3] = bfhi(u_[1][s3].y); \
                pv[0] = bflo(u_[0][s3].x); pv[1] = bfhi(u_[0][s3].x); pv[2] = bflo(u_[0][s3].y); pv[3] = bfhi(u_[0][s3].y); \
                nx[0] = bflo(u_[2][s3].x); nx[1] = bfhi(u_[2][s3].x); nx[2] = bflo(u_[2][s3].y); nx[3] = bfhi(u_[2][s3].y); \
                _Pragma("unroll") for (int q = 0; q < 4; ++q) us[s3][q] = cu[q] + m0[s3][q] * (pv[q] - cu[q]) + m1[s3][q] * (nx[q] - cu[q]); } \
            float dwv[4], dav[4], av[4], dc[4], kr[4]; \
            dwv[0] = bflo(dw_.x); dwv[1] = bfhi(dw_.x); dwv[2] = bflo(dw_.y); dwv[3] = bfhi(dw_.y); dav[0] = bflo(da_.x); dav[1] = bfhi(da_.x); dav[2] = bflo(da_.y); dav[3] = bfhi(da_.y); \
            float ss = 0.f; \
            _Pragma("unroll") for (int q = 0; q < 4; ++q) { av[q] = sigm(a0c[q] + dav[q]); dc[q] = __expf(-0.6065306597126334f * sigm(w0c[q] + dwv[q])); kr[q] = us[1][q] * kkc[q]; ss += kr[q] * kr[q]; } \
            ss = rowsum16(ss); const float rn = rsqrtf(ss + 1e-6f); \
            float* d_ = tl + ((buf) * 16 + st) * 384 + cq * 4; \
            *(float4*)(d_) = make_float4(us[0][0], us[0][1], us[0][2], us[0][3]); *(float4*)(d_ + 64) = make_float4(dc[0], dc[1], dc[2], dc[3]); \
            *(float4*)(d_ + 128) = make_float4(us[1][0] * (1.f + (av[0] - 1.f) * kac[0]), us[1][1] * (1.f + (av[1] - 1.f) * kac[1]), us[1][2] * (1.f + (av[2] - 1.f) * kac[2]), us[1][3] * (1.f + (av[3] - 1.f) * kac[3])); \
            *(float4*)(d_ + 192) = make_float4(kr[0] * rn, kr[1] * rn, kr[2] * rn, kr[3] * rn); *(float4*)(d_ + 256) = make_float4(kr[0] * rn * av[0], kr[1] * rn * av[1], kr[2] * rn * av[2], kr[3] * rn * av[3]); \
            *(float4*)(d_ + 320) = make_float4(us[2][0], us[2][1], us[2][2], us[2][3]); }
        RL(0, au, adw, ada); RS(0, au, adw, ada); RL(1, au, adw, ada);
        __syncthreads();
        for (int tile = 0; tile < 256; ++tile) {
            if (tile + 2 < 256) RL(tile + 2, bu, bdw, bda);
            if (tile + 1 < 256) RS((tile + 1) & 1, au, adw, ada);
#pragma unroll
            for (int a = 0; a < 3; ++a)
#pragma unroll
                for (int c = 0; c < 3; ++c) au[a][c] = bu[a][c];
            adw = bdw; ada = bda;
            __syncthreads();
        }
#undef RL
#undef RS
    } else {
        __builtin_amdgcn_s_setprio(3);
        const int e = tid >> 3, j = tid & 7, vrow = half * 32 + e;
        f32x2_t s2[4];
#pragma unroll
        for (int i = 0; i < 4; ++i) s2[i] = (f32x2_t){0.f, 0.f};
        __syncthreads();
        for (int tile = 0; tile < 256; ++tile) {
            const int buf = tile & 1;
            if (tile > 0) SCAN_FLUSH(tile - 1, buf ^ 1, 512 + hh * 64 + half * 32);
            float oreg[16];
            f32x2_t rb[3][4], wb[3][4], kb[3][4], kkb[3][4], kab[3][4]; float vb[3];
#define RW_LDSTEP(step_, sl_) { const float* bp = tl + (buf * 16 + (step_)) * 384 + j * 8; \
                _Pragma("unroll") for (int i = 0; i < 2; ++i) { const float4 rv = *(const float4*)(bp + 4 * i), wv = *(const float4*)(bp + 64 + 4 * i), kv = *(const float4*)(bp + 128 + 4 * i), kkv = *(const float4*)(bp + 192 + 4 * i), kav = *(const float4*)(bp + 256 + 4 * i); \
                    rb[sl_][2 * i] = (f32x2_t){rv.x, rv.y}; rb[sl_][2 * i + 1] = (f32x2_t){rv.z, rv.w}; wb[sl_][2 * i] = (f32x2_t){wv.x, wv.y}; wb[sl_][2 * i + 1] = (f32x2_t){wv.z, wv.w}; \
                    kb[sl_][2 * i] = (f32x2_t){kv.x, kv.y}; kb[sl_][2 * i + 1] = (f32x2_t){kv.z, kv.w}; kkb[sl_][2 * i] = (f32x2_t){kkv.x, kkv.y}; kkb[sl_][2 * i + 1] = (f32x2_t){kkv.z, kkv.w}; \
                    kab[sl_][2 * i] = (f32x2_t){kav.x, kav.y}; kab[sl_][2 * i + 1] = (f32x2_t){kav.z, kav.w}; } \
                vb[sl_] = tl[(buf * 16 + (step_)) * 384 + 320 + vrow]; }
            RW_LDSTEP(0, 0); RW_LDSTEP(1, 1);
#pragma unroll
            for (int step = 0; step < 16; ++step) {
                const int cs = step % 3;
                if (step < 14) RW_LDSTEP(step + 2, (step + 2) % 3);
                asm volatile("" ::: "memory");
                f32x2_t a0 = kkb[cs][0] * s2[0], a1 = kkb[cs][1] * s2[1]; a0 = fma2(kkb[cs][2], s2[2], a0); a1 = fma2(kkb[cs][3], s2[3], a1); a0 = a0 + a1;
                const float sa = rowsum8(a0.x + a0.y);
                const f32x2_t nsa = (f32x2_t){-sa, -sa}, v2 = (f32x2_t){vb[cs], vb[cs]};
#pragma unroll
                for (int i = 0; i < 4; ++i) s2[i] = fma2(v2, kb[cs][i], fma2(nsa, kab[cs][i], s2[i] * wb[cs][i]));
                f32x2_t b0 = rb[cs][0] * s2[0], b1 = rb[cs][1] * s2[1]; b0 = fma2(rb[cs][2], s2[2], b0); b1 = fma2(rb[cs][3], s2[3], b1); b0 = b0 + b1;
                oreg[step] = rowsum8(b0.x + b0.y);
            }
#undef RW_LDSTEP
#pragma unroll
            for (int step = 0; step < 16; ++step) ot[((buf * 16 + step) * 32 + e) * 8 + j] = oreg[step];
            __syncthreads();
        }
        SCAN_FLUSH(255, 1, 512 + hh * 64 + half * 32);
        __builtin_amdgcn_s_setprio(0);
    }
    __syncthreads();
}
#undef SCAN_TOK
#undef SCAN_FLUSH

__device__ __forceinline__ void phase_post1(const Params& p, float* lds, int tid, int bid, int nb) {
    const int wave = tid >> 6, lane = tid & 63;
    bf16_t* MIX = (bf16_t*)(p.ws + OFF_MIX); const bf16_t* OB = (const bf16_t*)((unsigned char*)p.out + DO_OB); const bf16_t* P1 = (const bf16_t*)(p.ws + OFF_P);
    { const float* nw = p.in[20]; float nw8[8];
#pragma unroll
      for (int i = 0; i < 8; ++i) nw8[i] = nw[(lane & 15) * 8 + i];
#pragma unroll 2
      for (int tk = bid * 8 + wave; tk < 16384; tk += nb * 8) { const size_t o = (size_t)tk * 1024 + lane * 8;
          gate_norm_token(MIX + o, OB + o, P1 + (size_t)tk * 4352 + 2048 + lane * 8, nw8); } }
    { const float* mu = p.in[21]; const float* g2 = p.in[26]; const bf16_t* AA = (const bf16_t*)(p.ws + OFF_AA);
      float* sg = lds; float* gl = lds + 2048;
      const int cb = lane * 8;
      float m0[3][8], m1[3][8], a0v[8], kav[8], rkv[8], lwv[8], lbv[8];
#pragma unroll
      for (int i = 0; i < 8; ++i) {
#pragma unroll
          for (int s3 = 0; s3 < 3; ++s3) { m0[s3][i] = mu[s3 * 512 + cb + i]; m1[s3][i] = mu[1792 + s3 * 512 + cb + i]; }
          a0v[i] = p.in[24][cb + i]; kav[i] = p.in[28][cb + i]; rkv[i] = p.in[29][cb + i]; lwv[i] = p.in[30][cb + i]; lbv[i] = p.in[31][cb + i]; }
      for (int it = bid; it < 1024; it += nb) {
#pragma unroll
          for (int k = 0; k < 4; ++k) { const int idx = tid + 512 * k, tt = idx >> 7, r = idx & 127, tk = it * 16 + tt; sg[r * 16 + tt] = sigm(rw_shift(P1, mu, tk, tk & 4095, 1664 + r)); }
          __syncthreads();
          { float acc[16];
#pragma unroll
            for (int i = 0; i < 16; ++i) acc[i] = 0.f;
#pragma unroll 4
            for (int r = 0; r < 128; ++r) { const float gv = g2[r * 512 + tid];
#pragma unroll
                for (int i4 = 0; i4 < 4; ++i4) { const float4 sv = *(const float4*)(sg + r * 16 + i4 * 4);
                    acc[i4 * 4 + 0] += sv.x * gv; acc[i4 * 4 + 1] += sv.y * gv; acc[i4 * 4 + 2] += sv.z * gv; acc[i4 * 4 + 3] += sv.w * gv; } }
#pragma unroll
            for (int i = 0; i < 16; ++i) gl[i * 512 + tid] = acc[i]; }
          __syncthreads();
#pragma unroll 1
          for (int ps = 0; ps < 2; ++ps) { const int tt = wave + 8 * ps, tk = it * 16 + tt, t = tk & 4095;
              const bf16_t* row = P1 + (size_t)tk * 4352 + 2560 + cb; const bool hp = t > 0, hn = t < 4095; const int po = hp ? -4352 : 0, no = hn ? 4352 : 0;
              float us[3][8];
#pragma unroll
              for (int s3 = 0; s3 < 3; ++s3) { const uint4 c4 = *(const uint4*)(row + s3 * 512), p4 = *(const uint4*)(row + po + s3 * 512), n4 = *(const uint4*)(row + no + s3 * 512);
                  const unsigned cw[4] = {c4.x, c4.y, c4.z, c4.w}, pw[4] = {p4.x, p4.y, p4.z, p4.w}, nw_[4] = {n4.x, n4.y, n4.z, n4.w};
#pragma unroll
                  for (int q = 0; q < 4; ++q) { const float c0 = bflo(cw[q]), c1 = bfhi(cw[q]);
                      const float p0 = hp ? bflo(pw[q]) : 0.f, p1 = hp ? bfhi(pw[q]) : 0.f, n0_ = hn ? bflo(nw_[q]) : 0.f, n1_ = hn ? bfhi(nw_[q]) : 0.f;
                      us[s3][2 * q] = c0 + m0[s3][2 * q] * (p0 - c0) + m1[s3][2 * q] * (n0_ - c0);
                      us[s3][2 * q + 1] = c1 + m0[s3][2 * q + 1] * (p1 - c1) + m1[s3][2 * q + 1] * (n1_ - c1); } }
              const uint4 a4 = *(const uint4*)(AA + (size_t)tk * 512 + cb); const unsigned aw[4] = {a4.x, a4.y, a4.z, a4.w};
              const size_t o = (size_t)tk * 1024 + 512 + cb;
              const uint4 f4 = *(const uint4*)(MIX + o), b4 = *(const uint4*)(OB + o); const unsigned fw[4] = {f4.x, f4.y, f4.z, f4.w}, bw[4] = {b4.x, b4.y, b4.z, b4.w};
              float y[8]; float d0 = 0.f, d1 = 0.f;
#pragma unroll
              for (int q = 0; q < 4; ++q) {
                  const float av0 = sigm(a0v[2 * q] + bflo(aw[q])), av1 = sigm(a0v[2 * q + 1] + bfhi(aw[q]));
                  const float kp0 = us[1][2 * q] * (1.f + (av0 - 1.f) * kav[2 * q]), kp1 = us[1][2 * q + 1] * (1.f + (av1 - 1.f) * kav[2 * q + 1]);
                  d0 += us[0][2 * q] * kp0 * rkv[2 * q] + us[0][2 * q + 1] * kp1 * rkv[2 * q + 1];
                  y[2 * q] = bflo(fw[q]) + bflo(bw[q]); y[2 * q + 1] = bfhi(fw[q]) + bfhi(bw[q]); d1 += y[2 * q] + y[2 * q + 1]; }
              d0 = rowsum8(d0); d1 = rowsum8(d1);
              const float mean = d1 * (1.f / 64.f); float vs_ = 0.f;
#pragma unroll
              for (int i = 0; i < 8; ++i) { y[i] -= mean; vs_ += y[i] * y[i]; }
              const float rstd = rsqrtf(rowsum8(vs_) * (1.f / 64.f) + 64e-5f);
              const float4 g0 = *(const float4*)(gl + tt * 512 + cb), g1 = *(const float4*)(gl + tt * 512 + cb + 4); const float gg[8] = {g0.x, g0.y, g0.z, g0.w, g1.x, g1.y, g1.z, g1.w};
              float ov[8];
#pragma unroll
              for (int i = 0; i < 8; ++i) ov[i] = (y[i] * rstd * lwv[i] + lbv[i] + d0 * us[2][i]) * gg[i];
              uint4 w; w.x = cvt_pk_bf16(ov[0], ov[1]); w.y = cvt_pk_bf16(ov[2], ov[3]); w.z = cvt_pk_bf16(ov[4], ov[5]); w.w = cvt_pk_bf16(ov[6], ov[7]);
              *(uint4*)(MIX + o) = w; }
          __syncthreads();
      } }
}


__global__ void __launch_bounds__(512, 2) hybrid_fwd(Params p) {
    extern __shared__ __attribute__((aligned(16))) unsigned char shm[];
    cg::grid_group grid = cg::this_grid();
    const int tid = threadIdx.x, bid = blockIdx.x, nb = gridDim.x;
    float* lds = (float*)shm; unsigned char* ws = p.ws;
    bf16_t* XB = (bf16_t*)(ws + OFF_XB); bf16_t* MIX = (bf16_t*)(ws + OFF_MIX); bf16_t* Pb = (bf16_t*)(ws + OFF_P); float* TMPP = (float*)(ws + OFF_P);
    const float* lng = p.in[33]; const float* lnb = p.in[34];

    volatile LAS unsigned* xst = (volatile LAS unsigned*)(shm + 131072 + 1024);
    if (tid < 4) xst[tid] = 0u;
    __syncthreads();
    const XcdBarrier xb = xcd_barrier_post((unsigned*)(ws + OFF_BAR), xst);
    phase_prep(p, lds, tid, bid, nb);
    xcd_barrier(xb);
    { EpiBf<0> e1; e1.O = (bf16_t*)(ws + OFF_PH); e1.ldc = 16384; run_gemm(shm, (const bf16_t*)(ws + OFF_EV_IN), XB, 1536, 16384, 1024, e1, bid);
      EpiBf<0> e2; e2.O = (bf16_t*)(ws + OFF_PG); e2.ldc = 2304; run_gemm(shm, XB, (const bf16_t*)(ws + OFF_EV_IN) + (size_t)1536 * 1024, 16384, 2304, 1024, e2, (bid + (nb >> 1)) % nb); }
    xcd_barrier(xb);
    phase_gdn_prep(p, tid, bid, nb);
    xcd_barrier(xb);
    if (bid < 128) gdn_scan(p, bid, lds, tid);
    else { for (int c = bid - 128; c < 512; c += nb - 128) hyena_channel(p, c, bid - 128, lds, tid);
           prep_weights_a(p, lds, tid, bid - 128, nb - 128); }
    grid.sync();
    phase_post0(p, lds, tid, bid, nb);
    xcd_barrier(xb);
    { EpiRes<false> e; e.C = TMPP; e.res = p.in[0]; run_gemm(shm, MIX, (const bf16_t*)(ws + OFF_EV_OUT), 16384, 1024, 1024, e, bid); }
    xcd_barrier(xb);
    phase_ln<false>(TMPP, lng, lnb, XB, nullptr, tid, bid, nb);
    xcd_barrier(xb);
    { EpiBf<1> e; e.O = Pb; e.ldc = 4096; run_gemm(shm, XB, (const bf16_t*)(ws + OFF_W1_0), 16384, 4096, 1024, e, bid); }
    xcd_barrier(xb);
    { EpiRes<true> e; e.C = p.out; e.res = XB; run_gemm(shm, Pb, (const bf16_t*)(ws + OFF_W2_0), 16384, 1024, 4096, e, bid); }
    xcd_barrier(xb);
    phase_ln<false>(p.out, lng + 1024, lnb + 1024, XB, nullptr, tid, bid, nb);
    xcd_barrier(xb);
    { EpiBf<0> e; e.O = Pb; e.ldc = 4352; run_gemm(shm, XB, (const bf16_t*)(ws + OFF_OD_IN), 16384, 4352, 1024, e, bid); }
    xcd_barrier(xb);
    phase_rw_lora(p, lds, tid, bid, nb);
    xcd_barrier(xb);
    if (bid < 128) { hgrn_scan(p, bid, lds, tid); prep_weights_b(p, lds, tid, bid, 128); }
    else for (int it = bid - 128; it < 128; it += nb - 128) rwkv_scan(p, it, lds, tid);
    xcd_barrier(xb);
    phase_post1(p, lds, tid, bid, nb);
    xcd_barrier(xb);
    { EpiRes<true> e; e.C = TMPP; e.res = XB; run_gemm(shm, MIX, (const bf16_t*)(ws + OFF_OD_OUT), 16384, 1024, 1024, e, bid); }
    xcd_barrier(xb);
    phase_ln<false>(TMPP, lng + 2048, lnb + 2048, XB, nullptr, tid, bid, nb);
    xcd_barrier(xb);
    { EpiBf<1> e; e.O = Pb; e.ldc = 4096; run_gemm(shm, XB, (const bf16_t*)(ws + OFF_W1_1), 16384, 4096, 1024, e, bid); }
    xcd_barrier(xb);
    { EpiRes<true> e; e.C = p.out; e.res = XB; run_gemm(shm, Pb, (const bf16_t*)(ws + OFF_W2_1), 16384, 1024, 4096, e, bid); }
    xcd_barrier(xb);
    phase_ln<true>(p.out, lng + 3072, lnb + 3072, nullptr, p.out, tid, bid, nb);
}

extern "C" void kernel_launch(void* const* d_in, const int* in_sizes, int n_in, void* d_out, int out_size, void* d_ws, size_t ws_size, hipStream_t stream) {
    static int grid_blocks = 0;
    if (!grid_blocks) {
        int dev = 0, cus = 0, per_cu = 0;
        hipGetDevice(&dev);
        hipDeviceGetAttribute(&cus, hipDeviceAttributeMultiprocessorCount, dev);
        hipFuncSetAttribute((const void*)hybrid_fwd, hipFuncAttributeMaxDynamicSharedMemorySize, LDS_BYTES);
        hipOccupancyMaxActiveBlocksPerMultiprocessor(&per_cu, (const void*)hybrid_fwd, 512, LDS_BYTES);
        if (per_cu < 1) { fprintf(stderr, "kernel_launch: occupancy query says %d blocks per CU\n", per_cu); per_cu = 1; }
        grid_blocks = cus * per_cu;
        if (n_in != 37 || ws_size < 254 * MBy) fprintf(stderr, "kernel_launch: unexpected n_in %d / ws_size %zu\n", n_in, ws_size);
    }
    hipMemsetAsync((unsigned char*)d_ws + OFF_BAR, 0, XCD_BAR_WORDS * sizeof(unsigned), stream);
    Params p{};
    for (int i = 0; i < 37; ++i) p.in[i] = (const float*)d_in[i];
    p.out = (float*)d_out; p.ws = (unsigned char*)d_ws;
    void* args[] = {&p};
    hipError_t e = hipLaunchCooperativeKernel((const void*)hybrid_fwd, dim3(grid_blocks), dim3(512), args, LDS_BYTES, stream);
    if (e != hipSuccess) fprintf(stderr, "cooperative launch failed: %s (grid %d)\n", hipGetErrorString(e), grid_blocks);
}
```

```cpp
#include <hip/hip_runtime.h>
#include <hip/hip_cooperative_groups.h>
#include <cstdio>
namespace cg = cooperative_groups;
namespace pg8 {
#define PG8_LAS __attribute__((address_space(3)))
typedef unsigned short bf16_t;
typedef short bf16x8 __attribute__((ext_vector_type(8)));
typedef float f32x4 __attribute__((ext_vector_type(4)));
typedef unsigned u32x4 __attribute__((ext_vector_type(4)));
constexpr int BM = 256, BK = 64, HALF = 128, HTB = HALF * BK * 2  , STAGE_BYTES = 8 * HTB, NXCD = 8, WGM = 8;

__host__ __device__ __forceinline__ int lds_byte(int r, int c) { const int st = (r >> 4) * 2 + (c >> 5), rr = r & 15, cc = c & 31, ob = rr * 64 + cc * 2; return st * 1024 + (ob ^ (((ob >> 9) & 1) << 5)); }
__host__ __device__ __forceinline__ void stage_rc(int b, int& R, int& C) { const int st = b / 1024, sb = b % 1024, swz = sb ^ (((sb >> 9) & 1) << 5); R = (st >> 1) * 16 + swz / 64; C = (st & 1) * 32 + (swz % 64) / 2; }
__host__ __device__ __forceinline__ int perm32(int rho) { const int n = rho >> 4, i = rho & 15; return 8 * (i >> 2) + 4 * n + (i & 3); }

struct Unit { int pm, pn; };
struct Gemm { const bf16_t* A; const bf16_t* Bt; int M, N, K; };

struct StaticOrder {
    int nM, nN, nwg, G, c;
    __host__ __device__ void init(int M, int N, int G_, int c_) { nM = M / BM; nN = N / BM; nwg = nM * nN; G = G_; c = c_; }
    __host__ __device__ bool next(int i, Unit& u) const {
        const long L = (long)i * G + c; if (L >= nwg) return false;
        int wgid = (int)L; { const int q = nwg / NXCD, r = nwg % NXCD, xcd = wgid % NXCD, off = wgid / NXCD; wgid = (xcd < r ? xcd * (q + 1) : r * (q + 1) + (xcd - r) * q) + off; }
        const int nig = WGM * nN, gid = wgid / nig, fm = gid * WGM, gsz = (nM - fm) < WGM ? (nM - fm) : WGM;
        u.pm = fm + ((wgid % nig) % gsz); u.pn = (wgid % nig) / gsz; return true;
    }
    __device__ __forceinline__ void a_ready(const Unit&) const {}
    __device__ __forceinline__ void done(const Unit&) const {}
};
__device__ __forceinline__ unsigned cvt_pk_bf16(float lo, float hi) { unsigned r; asm volatile("v_cvt_pk_bf16_f32 %0, %1, %2" : "=v"(r) : "v"(lo), "v"(hi)); return r; }
template <class Epi, class Sched>
__device__ __forceinline__ void gemm_phase(PG8_LAS unsigned char* lds, const Gemm g, const Sched& S, const Epi& E) {
    const int tid = threadIdx.x, wid = __builtin_amdgcn_readfirstlane(tid >> 6), lane = tid & 63, wr = wid >> 2, wc = wid & 3, fr = lane & 15, fq = lane >> 4;
    const int K = g.K, nt = K / BK;
    unsigned voffA[2], voffB[2];
#pragma unroll
    for (int i = 0; i < 2; ++i) { int R, C; stage_rc(tid * 16 + i * 8192, R, C); const int Rb = Epi::PERM ? ((R & ~31) + perm32(R & 31)) : R;
        voffA[i] = (unsigned)(R * K + C) * 2u; voffB[i] = (unsigned)(Rb * K + C) * 2u; }
    const size_t kstep = (size_t)(BK * 2);
    const size_t hstep = (size_t)HALF * K * 2;
    const size_t tstep = 2 * hstep;
    const unsigned ldsw = (unsigned)wid * 1024u;
    const int aoff = lds_byte(wr * 64 + fr, fq * 8), boff = lds_byte(wc * 32 + fr, fq * 8);
#define PG8_SA(b, h) (((b) * 2 + (h)) * HTB)
#define PG8_SB(b, h) ((4 + (b) * 2 + (h)) * HTB)
#define PG8_STAGE(bufoff, gbase, voff) do { _Pragma("unroll") for (int _i = 0; _i < 2; ++_i) \
        __builtin_amdgcn_global_load_lds((const unsigned*)((const char*)(gbase) + (voff)[_i]), (PG8_LAS unsigned*)(lds + (bufoff) + ldsw + _i * 8192), 16, 0, 0); } while (0)
#define PG8_LDA(dst, b, h) do { _Pragma("unroll") for (int m = 0; m < 4; ++m) _Pragma("unroll") for (int k = 0; k < 2; ++k) dst[m][k] = *(const PG8_LAS bf16x8*)(lds + PG8_SA(b, h) + aoff + m * 2048 + k * 1024); } while (0)
#define PG8_LDB(dst, b, h) do { _Pragma("unroll") for (int n = 0; n < 2; ++n) _Pragma("unroll") for (int k = 0; k < 2; ++k) dst[n][k] = *(const PG8_LAS bf16x8*)(lds + PG8_SB(b, h) + boff + n * 2048 + k * 1024); } while (0)
#define PG8_MMA(ai, bj, At, Bt) do { __builtin_amdgcn_s_setprio(1); _Pragma("unroll") for (int m = 0; m < 4; ++m) _Pragma("unroll") for (int n = 0; n < 2; ++n) _Pragma("unroll") for (int k = 0; k < 2; ++k) \
        acc[ai][bj][m][n] = __builtin_amdgcn_mfma_f32_16x16x32_bf16(Bt[n][k], At[m][k], acc[ai][bj][m][n], 0, 0, 0); __builtin_amdgcn_s_setprio(0); } while (0)
#define PG8_WAIT_V(n) asm volatile("s_waitcnt vmcnt(" #n ")" ::: "memory")
#define PG8_WAIT_L(n) asm volatile("s_waitcnt lgkmcnt(" #n ")" ::: "memory")
#define PG8_BAR __builtin_amdgcn_s_barrier()
#define PG8_SCHED __builtin_amdgcn_sched_barrier(0)
    Unit cur, nxt; int ui = 0;
    if (!S.next(0, cur)) return;
    f32x4 acc[2][2][4][2];
#pragma unroll
    for (int a = 0; a < 2; ++a)
#pragma unroll
        for (int b = 0; b < 2; ++b)
#pragma unroll
            for (int m = 0; m < 4; ++m)
#pragma unroll
                for (int n = 0; n < 2; ++n) acc[a][b][m][n] = (f32x4){0.f, 0.f, 0.f, 0.f};
    bf16x8 At[4][2], B0[2][2], B1[2][2];
    const char* cA = (const char*)g.A + (size_t)cur.pm * tstep; const char* cB = (const char*)g.Bt + (size_t)cur.pn * tstep;
    S.a_ready(cur);
    PG8_STAGE(PG8_SB(0, 0), cB, voffB); PG8_STAGE(PG8_SA(0, 0), cA, voffA); PG8_STAGE(PG8_SB(0, 1), cB + hstep, voffB); PG8_STAGE(PG8_SA(0, 1), cA + hstep, voffA);
    if (wr == 1) PG8_BAR;
    PG8_WAIT_V(4); PG8_BAR;
    PG8_STAGE(PG8_SB(1, 0), cB + kstep, voffB); PG8_STAGE(PG8_SA(1, 0), cA + kstep, voffA); PG8_STAGE(PG8_SB(1, 1), cB + hstep + kstep, voffB);
    PG8_WAIT_V(6); PG8_BAR;
    for (;;) {
        const bool has_next = S.next(ui + 1, nxt);
        const char* nA = has_next ? (const char*)g.A + (size_t)nxt.pm * tstep : cA; const char* nB = has_next ? (const char*)g.Bt + (size_t)nxt.pn * tstep : cB;
        for (int t = 0; t < nt; t += 2) {
            const bool last = (t == nt - 2);
            const char* a1 = cA + (size_t)(t + 1) * kstep;
            const char* a2 = last ? nA : cA + (size_t)(t + 2) * kstep; const char* b2 = last ? nB : cB + (size_t)(t + 2) * kstep;
            const char* a3 = a2 + kstep; const char* b3 = b2 + kstep;
            if (last && has_next) S.a_ready(nxt);
            PG8_LDB(B0, 0, 0); PG8_SCHED; PG8_LDA(At, 0, 0); PG8_STAGE(PG8_SA(1, 1), a1 + hstep, voffA);
            PG8_WAIT_L(8); PG8_BAR; PG8_WAIT_L(0); PG8_MMA(0, 0, At, B0); PG8_BAR; PG8_SCHED;
            PG8_LDB(B1, 0, 1); PG8_STAGE(PG8_SB(0, 0), b2, voffB);
            PG8_BAR; PG8_WAIT_L(0); PG8_MMA(0, 1, At, B1); PG8_BAR;
            PG8_LDA(At, 0, 1); PG8_STAGE(PG8_SA(0, 0), a2, voffA);
            PG8_BAR; PG8_WAIT_L(0); PG8_MMA(1, 0, At, B0); PG8_BAR; PG8_SCHED;
            PG8_STAGE(PG8_SB(0, 1), b2 + hstep, voffB);
            PG8_WAIT_V(6); PG8_BAR; PG8_MMA(1, 1, At, B1); PG8_BAR;
            PG8_LDB(B0, 1, 0); PG8_SCHED; PG8_LDA(At, 1, 0); PG8_STAGE(PG8_SA(0, 1), a2 + hstep, voffA);
            PG8_WAIT_L(8); PG8_BAR; PG8_WAIT_L(0); PG8_MMA(0, 0, At, B0); PG8_BAR; PG8_SCHED;
            PG8_LDB(B1, 1, 1); PG8_STAGE(PG8_SB(1, 0), b3, voffB);
            PG8_BAR; PG8_WAIT_L(0); PG8_MMA(0, 1, At, B1); PG8_BAR;
            PG8_LDA(At, 1, 1); PG8_STAGE(PG8_SA(1, 0), a3, voffA);
            PG8_BAR; PG8_WAIT_L(0); PG8_MMA(1, 0, At, B0); PG8_BAR; PG8_SCHED;
            PG8_STAGE(PG8_SB(1, 1), b3 + hstep, voffB);
            PG8_WAIT_V(6); PG8_BAR; PG8_MMA(1, 1, At, B1); PG8_BAR;
        }
        if constexpr (!Epi::AFTER_DRAIN) { E(acc, cur, wr, wc, fr, fq); S.done(cur); }
        if (!has_next) break;
#pragma unroll
        for (int a = 0; a < 2; ++a)
#pragma unroll
            for (int b = 0; b < 2; ++b)
#pragma unroll
                for (int m = 0; m < 4; ++m)
#pragma unroll
                    for (int n = 0; n < 2; ++n) acc[a][b][m][n] = (f32x4){0.f, 0.f, 0.f, 0.f};
        cur = nxt; cA = nA; cB = nB; ++ui;
    }
    PG8_WAIT_V(0);
    if (wr == 0) PG8_BAR;
    PG8_BAR;
    if constexpr (Epi::AFTER_DRAIN) { E.fused(acc, cur, wr, wc, fr, fq, lds, wid, lane); S.done(cur); }
#undef PG8_SA
#undef PG8_SB
#undef PG8_STAGE
#undef PG8_LDA
#undef PG8_LDB
#undef PG8_MMA
#undef PG8_WAIT_V
#undef PG8_WAIT_L
#undef PG8_BAR
#undef PG8_SCHED
}
}
#define XB_TMO      128
#define XB_XCNT(j)  (256  + 64 * (j))
#define XB_XSUB(j)  (1280 + 64 * (j))
#define XB_XGEN(j)  (2304 + 64 * (j))
#define XB_TOP      3328
#define XB_TOPGEN   3392
#define XCD_BAR_WORDS 3456
#define XB_SPIN_CAP (1u << 18)
#define LAS __attribute__((address_space(3)))

__device__ __forceinline__ unsigned xb_ld(unsigned* p)              { return __hip_atomic_load(p, __ATOMIC_RELAXED, __HIP_MEMORY_SCOPE_AGENT); }
__device__ __forceinline__ unsigned xb_add(unsigned* p, unsigned v) { return __hip_atomic_fetch_add(p, v, __ATOMIC_RELAXED, __HIP_MEMORY_SCOPE_AGENT); }
__device__ __forceinline__ unsigned xb_xcc_id() { return (unsigned)__builtin_amdgcn_s_getreg((3 << 11) | 20) & 0xFu; }
#define XB_SPIN(cond, bar) do { unsigned _sp = 0; while (cond) { __builtin_amdgcn_s_sleep(1); \
    if ((++_sp & 255u) == 0u) { if (xb_ld(&(bar)[XB_TMO])) break; if (_sp > XB_SPIN_CAP) { atomicAdd(&(bar)[XB_TMO], 1u); break; } } } } while (0)

struct XcdBarrier {
    unsigned* bar; unsigned x;
    volatile LAS unsigned* st;
};

__device__ __forceinline__ XcdBarrier xcd_barrier_post(unsigned* bar, volatile LAS unsigned* st) {
    XcdBarrier b; b.bar = bar; b.x = xb_xcc_id(); b.st = st;
    if (threadIdx.x == 0) (void)xb_add(&bar[XB_XCNT(b.x)], 1u);
    return b;
}
__device__ __forceinline__ void xcd_barrier_complete(unsigned* bar, unsigned x, unsigned& nloc, unsigned& nx) {
    const unsigned G = gridDim.x * gridDim.y * gridDim.z;
    unsigned sum, cnt, mine, sp = 0u;
    for (;;) {
        sum = 0u; cnt = 0u; mine = 0u;
#pragma unroll
        for (unsigned j = 0; j < 16; ++j) { const unsigned c = xb_ld(&bar[XB_XCNT(j)]); sum += c; cnt += (c > 0u) ? 1u : 0u; mine = (j == x) ? c : mine; }
        if (sum == G) break;
        __builtin_amdgcn_s_sleep(1);
        if ((++sp & 255u) == 0u) { if (xb_ld(&bar[XB_TMO])) break; if (sp > XB_SPIN_CAP) { atomicAdd(&bar[XB_TMO], 1u); break; } }
    }
    nloc = mine > 0u ? mine : 1u; nx = cnt > 0u ? cnt : 1u;
}

__device__ __forceinline__ void xcd_barrier(const XcdBarrier& b) {
    asm volatile("s_waitcnt vmcnt(0)" ::: "memory");
    __syncthreads();
    if (threadIdx.x == 0) {
        unsigned* bar = b.bar;
        __builtin_amdgcn_s_waitcnt(0);
        unsigned nloc = b.st[0], nx = b.st[1];
        if (nloc == 0u) { xcd_barrier_complete(bar, b.x, nloc, nx); b.st[0] = nloc; b.st[1] = nx; }
        const unsigned old = xb_add(&bar[XB_XSUB(b.x)], 1u);
        const unsigned gen = old / nloc;
        if (old + 1u == (gen + 1u) * nloc) {
            __builtin_amdgcn_fence(__ATOMIC_RELEASE, "agent");
            asm volatile("s_waitcnt vmcnt(0)" ::: "memory");
            const unsigned og = xb_add(&bar[XB_TOP], 1u);
            const unsigned tg = og / nx;
            if (og + 1u == (tg + 1u) * nx) xb_add(&bar[XB_TOPGEN], 1u);
            else XB_SPIN(xb_ld(&bar[XB_TOPGEN]) == tg, bar);
            __builtin_amdgcn_fence(__ATOMIC_ACQUIRE, "agent");
            xb_add(&bar[XB_XGEN(b.x)], 1u);
            asm volatile("s_waitcnt vmcnt(0)" ::: "memory");
        } else {
            XB_SPIN(xb_ld(&bar[XB_XGEN(b.x)]) == gen, bar);
            __builtin_amdgcn_fence(__ATOMIC_ACQUIRE, "agent");
            asm volatile("s_waitcnt vmcnt(0)" ::: "memory");
        }
    }
    __syncthreads();
}

using pg8::bf16_t; using pg8::f32x4; using pg8::u32x4; using pg8::cvt_pk_bf16;

constexpr size_t MBy = 1048576;
constexpr size_t OFF_OD_IN = 0, OFF_OD_OUT = OFF_OD_IN + 4352ull * 1024 * 2, OFF_W1_1 = OFF_OD_OUT + 2097152ull, OFF_W2_1 = OFF_W1_1 + 8388608ull;
constexpr size_t OFF_WT0 = OFF_W2_1 + 8388608ull;
constexpr size_t OFF_EV_IN = OFF_WT0, OFF_EV_OUT = OFF_EV_IN + 3840ull * 1024 * 2, OFF_W1_0 = OFF_EV_OUT + 2097152ull, OFF_W2_0 = OFF_W1_0 + 8388608ull;
static_assert(OFF_W2_0 + 8388608ull == 52 * MBy, "weights region");
constexpr size_t OFF_P = 52 * MBy, OFF_XB = 188 * MBy, OFF_MIX = 220 * MBy, OFF_H3 = 252 * MBy, OFF_SC = 253 * MBy;
constexpr size_t OFF_PH = OFF_P, OFF_PG = OFF_P + 48 * MBy, OFF_QKVP = OFF_P + 120 * MBy;
constexpr size_t OFF_AA = OFF_WT0;
constexpr size_t DO_OB = 0, DO_YA = 32 * MBy, DO_HF = 48 * MBy, DO_FG1 = 56 * MBy, DO_DW0 = 32 * MBy, DO_DW1 = 48 * MBy;
constexpr int LDS_BYTES = 131072 + 1024 + 16;
constexpr size_t OFF_BAR = 255 * MBy;
constexpr float ALPHA = 1.41421356237f;

struct Params { const float* in[37]; float* out; unsigned char* ws; };

__device__ __forceinline__ float bflo(unsigned u) { return __uint_as_float(u << 16); }
__device__ __forceinline__ float bfhi(unsigned u) { return __uint_as_float(u & 0xffff0000u); }
__device__ __forceinline__ float bf1(bf16_t b) { return __uint_as_float(((unsigned)b) << 16); }
__device__ __forceinline__ bf16_t f2bf(float f) { return (bf16_t)(cvt_pk_bf16(f, 0.f) & 0xffffu); }
__device__ __forceinline__ float sigm(float x) { return 1.f / (1.f + __expf(-x)); }
__device__ __forceinline__ float silu(float x) { return x / (1.f + __expf(-x)); }
__device__ __forceinline__ float wave_sum(float x) {
#pragma unroll
    for (int o = 32; o >= 1; o >>= 1) x += __shfl_xor(x, o);
    return x; }
#define DPP_ADD_ROR(x, ctl) x += __int_as_float(__builtin_amdgcn_update_dpp(0, __float_as_int(x), ctl, 0xf, 0xf, false))
__device__ __forceinline__ float rowsum16(float x) {
    DPP_ADD_ROR(x, 0x128); DPP_ADD_ROR(x, 0x124); DPP_ADD_ROR(x, 0x122); DPP_ADD_ROR(x, 0x121); return x; }
__device__ __forceinline__ float rowsum8(float x) {
    DPP_ADD_ROR(x, 0x141); DPP_ADD_ROR(x, 0xB1); DPP_ADD_ROR(x, 0x4E); return x; }
typedef float f32x2_t __attribute__((ext_vector_type(2)));
__device__ __forceinline__ f32x2_t fma2(f32x2_t a, f32x2_t b, f32x2_t c) { return __builtin_elementwise_fma(a, b, c); }
__device__ __forceinline__ void unpack8(uint4 r, float* d) {
    *(float4*)d = make_float4(bflo(r.x), bfhi(r.x), bflo(r.y), bfhi(r.y));
    *(float4*)(d + 4) = make_float4(bflo(r.z), bfhi(r.z), bflo(r.w), bfhi(r.w)); }

template <int ACT> struct EpiBf {
    static constexpr bool PERM = true, AFTER_DRAIN = false;
    bf16_t* O; int ldc;
    __device__ __forceinline__ void operator()(const f32x4 (&acc)[2][2][4][2], const pg8::Unit& u, int wr, int wc, int fr, int fq) const {
        const int row0 = u.pm * 256 + wr * 64 + fr, col0 = u.pn * 256 + wc * 32 + 8 * fq;
#pragma unroll
        for (int ai = 0; ai < 2; ++ai)
#pragma unroll
            for (int m = 0; m < 4; ++m) { bf16_t* rowp = O + (size_t)(row0 + ai * 128 + m * 16) * ldc + col0;
#pragma unroll
                for (int bj = 0; bj < 2; ++bj) { f32x4 v0 = acc[ai][bj][m][0], v1 = acc[ai][bj][m][1];
                    if (ACT == 1) {
#pragma unroll
                        for (int j = 0; j < 4; ++j) { float a = fmaxf(v0[j], 0.f), b = fmaxf(v1[j], 0.f); v0[j] = a * a; v1[j] = b * b; } }
                    u32x4 w; w.x = cvt_pk_bf16(v0[0], v0[1]); w.y = cvt_pk_bf16(v0[2], v0[3]); w.z = cvt_pk_bf16(v1[0], v1[1]); w.w = cvt_pk_bf16(v1[2], v1[3]);
                    *(u32x4*)(rowp + bj * 128) = w; } }
    }
};
template <bool RESBF> struct EpiRes {
    static constexpr bool PERM = false, AFTER_DRAIN = false;
    float* C; const void* res;
    __device__ __forceinline__ void operator()(const f32x4 (&acc)[2][2][4][2], const pg8::Unit& u, int wr, int wc, int fr, int fq) const {
        const int row0 = u.pm * 256 + wr * 64 + fr, col0 = u.pn * 256 + wc * 32 + 4 * fq;
#pragma unroll
        for (int ai = 0; ai < 2; ++ai)
#pragma unroll
            for (int m = 0; m < 4; ++m) { const size_t ro = (size_t)(row0 + ai * 128 + m * 16) * 1024 + col0;
#pragma unroll
                for (int bj = 0; bj < 2; ++bj)
#pragma unroll
                    for (int n = 0; n < 2; ++n) { const size_t o = ro + bj * 128 + n * 16; f32x4 r;
                        if (RESBF) { const uint2 w = *(const uint2*)((const bf16_t*)res + o); r = (f32x4){bflo(w.x), bfhi(w.x), bflo(w.y), bfhi(w.y)}; }
                        else r = *(const f32x4*)((const float*)res + o);
                        *(f32x4*)(C + o) = acc[ai][bj][m][n] + r * ALPHA; } }
    }
};
template <class Epi> __device__ __forceinline__ void run_gemm(unsigned char* shm, const bf16_t* A, const bf16_t* Bt, int M, int N, int K, const Epi& E, int c) {
    pg8::Gemm g; g.A = A; g.Bt = Bt; g.M = M; g.N = N; g.K = K;
    pg8::StaticOrder S; S.init(M, N, (int)gridDim.x, c);
    pg8::gemm_phase<Epi, pg8::StaticOrder>((PG8_LAS unsigned char*)shm, g, S, E);
    __syncthreads();
}

__device__ __forceinline__ void transpose_mat(const float* __restrict__ W, int K, int N, int Npad, bf16_t* __restrict__ Wt, float* lds, int tid, int bid, int nb) {
    const int ntk = K >> 6, ntiles = (Npad >> 6) * ntk;
    for (int tile = bid; tile < ntiles; tile += nb) {
        const int tn = tile / ntk, tk = tile - tn * ntk, n0 = tn << 6, k0 = tk << 6;
        { const int c4 = tid & 15, r = tid >> 4;
#pragma unroll
          for (int rr = 0; rr < 2; ++rr) { const int row = r + rr * 32, n = n0 + c4 * 4; float4 v = make_float4(0.f, 0.f, 0.f, 0.f);
              if (n < N) v = *(const float4*)(W + (size_t)(k0 + row) * N + n);
              float* d = lds + row * 65 + c4 * 4; d[0] = v.x; d[1] = v.y; d[2] = v.z; d[3] = v.w; } }
        __syncthreads();
        { const int n = tid >> 3, kc = tid & 7; u32x4 w;
          w.x = cvt_pk_bf16(lds[(kc * 8 + 0) * 65 + n], lds[(kc * 8 + 1) * 65 + n]); w.y = cvt_pk_bf16(lds[(kc * 8 + 2) * 65 + n], lds[(kc * 8 + 3) * 65 + n]);
          w.z = cvt_pk_bf16(lds[(kc * 8 + 4) * 65 + n], lds[(kc * 8 + 5) * 65 + n]); w.w = cvt_pk_bf16(lds[(kc * 8 + 6) * 65 + n], lds[(kc * 8 + 7) * 65 + n]);
          *(u32x4*)(Wt + (size_t)(n0 + n) * K + k0 + kc * 8) = w; }
        __syncthreads();
    }
}
__device__ __forceinline__ void prep_weights_a(const Params& p, float* lds, int tid, int bid, int nb) {
    unsigned char* ws = p.ws;
    __syncthreads();
    transpose_mat(p.in[17], 1024, 1024, 1024, (bf16_t*)(ws + OFF_EV_OUT), lds, tid, bid, nb);
    transpose_mat(p.in[35], 1024, 4096, 4096, (bf16_t*)(ws + OFF_W1_0), lds, tid, bid, nb);
    transpose_mat(p.in[36], 4096, 1024, 1024, (bf16_t*)(ws + OFF_W2_0), lds, tid, bid, nb);
    transpose_mat(p.in[18], 1024, 4352, 4352, (bf16_t*)(ws + OFF_OD_IN), lds, tid, bid, nb);
}
__device__ __forceinline__ void prep_weights_b(const Params& p, float* lds, int tid, int bid, int nb) {
    unsigned char* ws = p.ws;
    __syncthreads();
    transpose_mat(p.in[32], 1024, 1024, 1024, (bf16_t*)(ws + OFF_OD_OUT), lds, tid, bid, nb);
    transpose_mat(p.in[35] + (size_t)1024 * 4096, 1024, 4096, 4096, (bf16_t*)(ws + OFF_W1_1), lds, tid, bid, nb);
    transpose_mat(p.in[36] + (size_t)1024 * 4096, 4096, 1024, 1024, (bf16_t*)(ws + OFF_W2_1), lds, tid, bid, nb);
}
__device__ __forceinline__ void phase_prep(const Params& p, float* lds, int tid, int bid, int nb) {
    unsigned char* ws = p.ws;
    { const float4* x4 = (const float4*)p.in[0]; uint2* xb = (uint2*)(ws + OFF_XB);
#pragma unroll 2
      for (size_t i = (size_t)bid * 512 + tid; i < (size_t)16384 * 256; i += (size_t)nb * 512) { const float4 v = x4[i]; uint2 o; o.x = cvt_pk_bf16(v.x, v.y); o.y = cvt_pk_bf16(v.z, v.w); xb[i] = o; } }
    transpose_mat(p.in[1], 1024, 3596, 3840, (bf16_t*)(ws + OFF_EV_IN), lds, tid, bid, nb);
    { float* zs = lds; float* ha = lds + 8 * 36; float* hb = ha + 512; float* w1s = hb + 512; float* w2s = w1s + 33 * 64; float* w3s = w2s + 4096; float* H3 = (float*)(ws + OFF_H3);
      const float* b1 = p.in[5]; const float* b2 = p.in[7]; const float* b3 = p.in[9]; const float* fr = p.in[11];
      __syncthreads();
      for (int i = tid; i < 33 * 64; i += 512) w1s[i] = p.in[4][i];
      for (int i = tid; i < 4096; i += 512) { w2s[i] = p.in[6][i]; w3s[i] = p.in[8][i]; }
      const int pl = tid >> 6, j = tid & 63; const float fq = fr[j], bb1 = b1[j], bb2 = b2[j], bb3 = b3[j];
      __syncthreads();
      for (int it = bid; it < 512; it += nb) {
          const int pos = it * 8 + pl;
          if (j < 33) { const float pf = (float)pos; float val;
              if (j == 0) val = pf / 4095.f;
              else { const int bi = (j - 1) & 15; const float band = 1e-4f + (float)bi * ((15.f - 1e-4f) / 15.f); const float ang = band * (6.283185307179586f / 4096.f) * pf; val = (j <= 16) ? cosf(ang) : -sinf(ang); }
              zs[pl * 36 + j] = val; }
          __syncthreads();
          float acc = bb1;
#pragma unroll 11
          for (int i = 0; i < 33; ++i) acc += zs[pl * 36 + i] * w1s[i * 64 + j];
          ha[pl * 64 + j] = sinf(fq * acc);
          __syncthreads();
          acc = bb2;
#pragma unroll 16
          for (int i = 0; i < 64; ++i) acc += ha[pl * 64 + i] * w2s[i * 64 + j];
          hb[pl * 64 + j] = sinf(fq * acc);
          __syncthreads();
          acc = bb3;
#pragma unroll 16
          for (int i = 0; i < 64; ++i) acc += hb[pl * 64 + i] * w3s[i * 64 + j];
          H3[pos * 64 + j] = sinf(fq * acc);
          __syncthreads();
      } }
}

__device__ __forceinline__ void phase_gdn_prep(const Params& p, int tid, int bid, int nb) {
    const int wave = tid >> 6, lane = tid & 63;
    const bf16_t* PG = (const bf16_t*)(p.ws + OFF_PG); bf16_t* QK = (bf16_t*)(p.ws + OFF_QKVP); float* SC = (float*)(p.ws + OFF_SC);
    const float* cw = p.in[13];
    for (int it = bid * 8 + wave; it < 4096 * 3; it += nb * 8) {
        const int s3 = it % 3, tk0 = (it / 3) * 4, t0 = tk0 & 4095, cb = s3 * 512 + lane * 8;
        float acc[4][8];
#pragma unroll
        for (int o = 0; o < 4; ++o)
#pragma unroll
            for (int i = 0; i < 8; ++i) acc[o][i] = 0.f;
#pragma unroll
        for (int r = 0; r < 8; ++r) { const int tt = t0 + r - 2;
            if (tt >= 0 && tt < 4096) { const uint4 u4 = *(const uint4*)(PG + (size_t)(tk0 + r - 2) * 2304 + cb);
                float u[8]; u[0] = bflo(u4.x); u[1] = bfhi(u4.x); u[2] = bflo(u4.y); u[3] = bfhi(u4.y); u[4] = bflo(u4.z); u[5] = bfhi(u4.z); u[6] = bflo(u4.w); u[7] = bfhi(u4.w);
#pragma unroll
                for (int j = 0; j < 5; ++j) { const int o = r - j;
                    if (o >= 0 && o < 4) { const float4 w0 = *(const float4*)(cw + j * 1536 + cb), w1 = *(const float4*)(cw + j * 1536 + cb + 4);
                        acc[o][0] += w0.x * u[0]; acc[o][1] += w0.y * u[1]; acc[o][2] += w0.z * u[2]; acc[o][3] += w0.w * u[3];
                        acc[o][4] += w1.x * u[4]; acc[o][5] += w1.y * u[5]; acc[o][6] += w1.z * u[6]; acc[o][7] += w1.w * u[7]; } } } }
#pragma unroll
        for (int o = 0; o < 4; ++o) { const int tk = tk0 + o; float ss = 0.f;
#pragma unroll
            for (int i = 0; i < 8; ++i) { acc[o][i] = silu(acc[o][i]); ss += acc[o][i] * acc[o][i]; }
            float sc_ = 1.f;
            if (s3 < 2) { ss = rowsum16(ss); sc_ = rsqrtf(ss + 1e-6f) * (s3 == 0 ? 0.08838834764831845f : 1.f); }
            uint4 w; w.x = cvt_pk_bf16(acc[o][0] * sc_, acc[o][1] * sc_); w.y = cvt_pk_bf16(acc[o][2] * sc_, acc[o][3] * sc_); w.z = cvt_pk_bf16(acc[o][4] * sc_, acc[o][5] * sc_); w.w = cvt_pk_bf16(acc[o][6] * sc_, acc[o][7] * sc_);
            *(uint4*)(QK + (size_t)tk * 1536 + cb) = w;
            if (s3 == 0 && (lane & 15) < 3) { const int h = lane >> 4, sub = lane & 15; const bf16_t* row = PG + (size_t)tk * 2304; float val;
                if (sub == 0) val = sigm(bf1(row[2056 + h]));
                else { const int d = sub - 1; const float a = bf1(row[2048 + d * 4 + h]) + p.in[15][d * 4 + h]; const float sp = a > 20.f ? a : log1pf(expf(a)); val = expf(-expf(p.in[14][d * 4 + h]) * sp); }
                SC[((size_t)tk * 4 + h) * 4 + sub] = val; } }
    }
}

__device__ __forceinline__ float2 cmul(float2 a, float2 b) { return make_float2(a.x * b.x - a.y * b.y, a.x * b.y + a.y * b.x); }
__device__ __forceinline__ float2 cadd(float2 a, float2 b) { return make_float2(a.x + b.x, a.y + b.y); }
__device__ __forceinline__ float2 csub(float2 a, float2 b) { return make_float2(a.x - b.x, a.y - b.y); }
template <bool ZP> __device__ __forceinline__ void fft_fwd(float2* D, int tid) {
    for (int S = 4096; S >= 4; S >>= 2) {
        const int Q = S >> 1; const float inv = -0.5f / (float)S; const bool zp = ZP && S == 4096;
#pragma unroll 2
        for (int i = tid; i < 2048; i += 512) { const int k = i & (Q - 1), j = ((i - k) << 2) + k;
            const float2 x0 = D[j], x1 = D[j + Q]; float2 x2 = make_float2(0.f, 0.f), x3 = x2;
            if (!zp) { x2 = D[j + 2 * Q]; x3 = D[j + 3 * Q]; }
            const float rev = (float)k * inv;
            const float2 w1 = make_float2(__builtin_amdgcn_cosf(rev), __builtin_amdgcn_sinf(rev)), w2 = make_float2(w1.x * w1.x - w1.y * w1.y, 2.f * w1.x * w1.y);
            const float2 a0 = cadd(x0, x2), a2 = cmul(csub(x0, x2), w1), a1 = cadd(x1, x3), t = cmul(csub(x1, x3), w1), a3 = make_float2(t.y, -t.x);
            D[j] = cadd(a0, a1); D[j + Q] = cmul(csub(a0, a1), w2); D[j + 2 * Q] = cadd(a2, a3); D[j + 3 * Q] = cmul(csub(a2, a3), w2); }
        __syncthreads();
    }
#pragma unroll 2
    for (int i = tid; i < 4096; i += 512) { const float2 a = D[2 * i], b = D[2 * i + 1]; D[2 * i] = cadd(a, b); D[2 * i + 1] = csub(a, b); }
    __syncthreads();
}
__device__ __forceinline__ void fft_inv(float2* D, int tid) {
#pragma unroll 2
    for (int i = tid; i < 4096; i += 512) { const float2 a = D[2 * i], b = D[2 * i + 1]; D[2 * i] = cadd(a, b); D[2 * i + 1] = csub(a, b); }
    __syncthreads();
    for (int s = 2; s <= 2048; s <<= 2) {
        const float inv = 0.25f / (float)s; const bool last = s == 2048;
#pragma unroll 2
        for (int i = tid; i < 2048; i += 512) { const int k = i & (s - 1), j = ((i - k) << 2) + k;
            const float2 x0 = D[j], x1 = D[j + s], x2 = D[j + 2 * s], x3 = D[j + 3 * s];
            const float rev = (float)k * inv;
            const float2 v = make_float2(__builtin_amdgcn_cosf(rev), __builtin_amdgcn_sinf(rev)), u1 = make_float2(v.x * v.x - v.y * v.y, 2.f * v.x * v.y);
            float2 t = cmul(x1, u1); const float2 a0 = cadd(x0, t), a1 = csub(x0, t); t = cmul(x3, u1); const float2 a2 = cadd(x2, t), a3 = csub(x2, t);
            t = cmul(a2, v); D[j] = cadd(a0, t); if (!last) D[j + 2 * s] = csub(a0, t);
            t = cmul(a3, v); t = make_float2(-t.y, t.x); D[j + s] = cadd(a1, t); if (!last) D[j + 3 * s] = csub(a1, t); }
        __syncthreads();
    }
}
__device__ __forceinline__ float conv3(const bf16_t* row, int t, float w0, float w1, float w2, float bias) {
    const bf16_t* q = row + t;
    const bf16_t a = q[-1], b = q[0], c = q[1];
    const float um = t > 0 ? bf1(a) : 0.f, u0 = bf1(b), up = t < 4095 ? bf1(c) : 0.f;
    return w0 * um + w1 * u0 + w2 * up + bias; }
__device__ __forceinline__ void hyena_channel(const Params& p, int c, int slot, float* lds, int tid) {
    float2* D = (float2*)lds; float* Z = lds + 16384; float* w4s = lds + 32768;
    float2* HfG = (float2*)((unsigned char*)p.out + DO_HF) + (size_t)slot * 8192;
    const bf16_t* PH = (const bf16_t*)(p.ws + OFF_PH); const float* H3 = (const float*)(p.ws + OFF_H3);
    const float* cw = p.in[2]; const float* cb = p.in[3]; const float* w4 = p.in[10]; const float* skp = p.in[12];
    bf16_t* YA = (bf16_t*)((unsigned char*)p.out + DO_YA);
    __syncthreads();
    { const int ch = 1024 + c; const float w0 = cw[ch], w1 = cw[1536 + ch], w2 = cw[3072 + ch], bb = cb[ch]; const bf16_t* row = PH + (size_t)ch * 16384;
#pragma unroll 2
      for (int idx = tid; idx < 16384; idx += 512) { const int t = idx & 4095; Z[idx] = conv3(row + (idx - t), t, w0, w1, w2, bb); } }
    const float delta = fabsf(-3.0701134573253944f + (float)c * ((-15.350567286626972f + 3.0701134573253944f) / 511.f));
    float* FG1 = (float*)((unsigned char*)p.out + DO_FG1) + (size_t)slot * 8192;
    if (tid < 256) w4s[tid] = w4[(tid & 63) * 2048 + (tid >> 6) * 512 + c];
    __syncthreads();
#pragma unroll 1
    for (int hlf = 0; hlf < 2; ++hlf) { float acc[4][4]; const int tb = tid + 2048 * hlf;
#pragma unroll
      for (int i = 0; i < 4; ++i) { acc[i][0] = 0.f; acc[i][1] = 0.f; acc[i][2] = 0.f; acc[i][3] = 0.f; }
#pragma unroll 1
      for (int jj = 0; jj < 64; jj += 4) {
          float4 hv[4];
#pragma unroll
          for (int i = 0; i < 4; ++i) hv[i] = *(const float4*)(H3 + (tb + 512 * i) * 64 + jj);
#pragma unroll
          for (int q = 0; q < 4; ++q) { const float4 wv = *(const float4*)(w4s + q * 64 + jj);
#pragma unroll
              for (int i = 0; i < 4; ++i) acc[i][q] += (hv[i].x * wv.x + hv[i].y * wv.y) + (hv[i].z * wv.z + hv[i].w * wv.w); } }
#pragma unroll
      for (int i = 0; i < 4; ++i) { const int t = tb + 512 * i; const float win = expf(-((float)t / 4095.f) * delta);
          const float hf0 = acc[i][0] * win, hb0 = acc[i][1] * win, hf1 = acc[i][2] * win, hb1 = acc[i][3] * win;
          if (t == 0) { D[0] = make_float2(hf0 + hb0, 0.f); D[4096] = make_float2(0.f, 0.f); FG1[0] = hf1 + hb1; FG1[4096] = 0.f; }
          else { D[t] = make_float2(hf0, 0.f); D[8192 - t] = make_float2(hb0, 0.f); FG1[t] = hf1; FG1[8192 - t] = hb1; } } }
#pragma unroll 1
    for (int o = 0; o < 2; ++o) {
        __syncthreads();
        if (o == 1) {
#pragma unroll 4
            for (int idx = tid; idx < 8192; idx += 512) D[idx] = make_float2(FG1[idx], 0.f); }
        __syncthreads();
        fft_fwd<false>(D, tid);
#pragma unroll 2
        for (int idx = tid; idx < 8192; idx += 512) HfG[idx] = D[idx];
        const float skip = skp[o * 512 + c];
        const int gch = o * 512 + c; const float g0 = cw[gch], g1 = cw[1536 + gch], g2 = cw[3072 + gch], gb = cb[gch];
#pragma unroll 1
        for (int pr = 0; pr < 2; ++pr) {
            __syncthreads();
#pragma unroll 2
            for (int t = tid; t < 4096; t += 512) D[t] = make_float2(Z[(2 * pr) * 4096 + t], Z[(2 * pr + 1) * 4096 + t]);
            __syncthreads();
            fft_fwd<true>(D, tid);
#pragma unroll 2
            for (int idx = tid; idx < 8192; idx += 512) { const float2 a = D[idx], hh = HfG[idx]; D[idx] = make_float2(a.x * hh.x - a.y * hh.y, a.x * hh.y + a.y * hh.x); }
            __syncthreads();
            fft_inv(D, tid);
            const bf16_t* grow = PH + (size_t)gch * 16384 + (2 * pr) * 4096;
#pragma unroll 2
            for (int t = tid; t < 4096; t += 512) { const float2 y = D[t];
                const float ga = conv3(grow, t, g0, g1, g2, gb), gbv = conv3(grow + 4096, t, g0, g1, g2, gb);
                Z[(2 * pr) * 4096 + t] = ga * (y.x * (1.f / 8192.f) + skip * Z[(2 * pr) * 4096 + t]);
                Z[(2 * pr + 1) * 4096 + t] = gbv * (y.y * (1.f / 8192.f) + skip * Z[(2 * pr + 1) * 4096 + t]); }
        }
    }
    __syncthreads();
#pragma unroll 2
    for (int idx = tid; idx < 16384; idx += 512) YA[(size_t)c * 16384 + idx] = f2bf(Z[idx]);
    __syncthreads();
}

__device__ __forceinline__ void gate_norm_token(bf16_t* mixp, const bf16_t* obp, const bf16_t* gp, const float (&nw8)[8]) {
    const uint4 uf = *(const uint4*)mixp, ub = *(const uint4*)obp, ug = *(const uint4*)gp;
    float v[8], g[8];
    v[0] = bflo(uf.x) + bflo(ub.x); v[1] = bfhi(uf.x) + bfhi(ub.x); v[2] = bflo(uf.y) + bflo(ub.y); v[3] = bfhi(uf.y) + bfhi(ub.y);
    v[4] = bflo(uf.z) + bflo(ub.z); v[5] = bfhi(uf.z) + bfhi(ub.z); v[6] = bflo(uf.w) + bflo(ub.w); v[7] = bfhi(uf.w) + bfhi(ub.w);
    g[0] = bflo(ug.x); g[1] = bfhi(ug.x); g[2] = bflo(ug.y); g[3] = bfhi(ug.y); g[4] = bflo(ug.z); g[5] = bfhi(ug.z); g[6] = bflo(ug.w); g[7] = bfhi(ug.w);
    float ss = 0.f;
#pragma unroll
    for (int i = 0; i < 8; ++i) ss += v[i] * v[i];
    const float r = rsqrtf(rowsum16(ss) * (1.f / 128.f) + 1e-6f);
#pragma unroll
    for (int i = 0; i < 8; ++i) v[i] = v[i] * r * nw8[i] * silu(g[i]);
    uint4 w; w.x = cvt_pk_bf16(v[0], v[1]); w.y = cvt_pk_bf16(v[2], v[3]); w.z = cvt_pk_bf16(v[4], v[5]); w.w = cvt_pk_bf16(v[6], v[7]);
    *(uint4*)mixp = w;
}
__device__ __forceinline__ void phase_post0(const Params& p, float* lds, int tid, int bid, int nb) {
    const int wave = tid >> 6, lane = tid & 63;
    bf16_t* MIX = (bf16_t*)(p.ws + OFF_MIX); const bf16_t* OB = (const bf16_t*)((unsigned char*)p.out + DO_OB); const bf16_t* PG = (const bf16_t*)(p.ws + OFF_PG);
    const float* nw = p.in[16];
    { float nw8[8];
#pragma unroll
      for (int i = 0; i < 8; ++i) nw8[i] = nw[(lane & 15) * 8 + i];
#pragma unroll 2
      for (int tk = bid * 8 + wave; tk < 16384; tk += nb * 8) { const size_t o = (size_t)tk * 1024 + 512 + lane * 8;
          gate_norm_token(MIX + o, OB + o, PG + (size_t)tk * 2304 + 1536 + lane * 8, nw8); } }
    const bf16_t* YA = (const bf16_t*)((unsigned char*)p.out + DO_YA); bf16_t* tl = (bf16_t*)lds;
    for (int tile = bid; tile < 8 * 256; tile += nb) { const int c0 = (tile & 7) * 64, t0 = (tile >> 3) * 64;
        { const int cr = tid >> 3, tc = tid & 7; *(uint4*)(tl + cr * 72 + tc * 8) = *(const uint4*)(YA + (size_t)(c0 + cr) * 16384 + t0 + tc * 8); }
        __syncthreads();
        { const int r = tid >> 3, cc = tid & 7; u32x4 w; unsigned short v[8];
#pragma unroll
          for (int i = 0; i < 8; ++i) v[i] = tl[(cc * 8 + i) * 72 + r];
          w.x = v[0] | ((unsigned)v[1] << 16); w.y = v[2] | ((unsigned)v[3] << 16); w.z = v[4] | ((unsigned)v[5] << 16); w.w = v[6] | ((unsigned)v[7] << 16);
          *(u32x4*)(MIX + (size_t)(t0 + r) * 1024 + c0 + cc * 8) = w; }
        __syncthreads();
    }
}

template <bool FINAL> __device__ __forceinline__ void phase_ln(const float* TMP, const float* g, const float* bt, bf16_t* XB, float* outf, int tid, int bid, int nb) {
    const int wave = tid >> 6, lane = tid & 63;
#pragma unroll 2
    for (int row = bid * 8 + wave; row < 16384; row += nb * 8) {
        float4 v[4]; float sm = 0.f;
#pragma unroll
        for (int i = 0; i < 4; ++i) { v[i] = *(const float4*)(TMP + (size_t)row * 1024 + i * 256 + lane * 4); sm += (v[i].x + v[i].y) + (v[i].z + v[i].w); }
        const float mean = wave_sum(sm) * (1.f / 1024.f); float sq = 0.f;
#pragma unroll
        for (int i = 0; i < 4; ++i) { v[i].x -= mean; v[i].y -= mean; v[i].z -= mean; v[i].w -= mean; sq += (v[i].x * v[i].x + v[i].y * v[i].y) + (v[i].z * v[i].z + v[i].w * v[i].w); }
        const float r = rsqrtf(wave_sum(sq) * (1.f / 1024.f) + 1e-5f);
#pragma unroll
        for (int i = 0; i < 4; ++i) { const int col = i * 256 + lane * 4; const float4 gg = *(const float4*)(g + col), bb = *(const float4*)(bt + col);
            const float y0 = v[i].x * r * gg.x + bb.x, y1 = v[i].y * r * gg.y + bb.y, y2 = v[i].z * r * gg.z + bb.z, y3 = v[i].w * r * gg.w + bb.w;
            if (FINAL) *(float4*)(outf + (size_t)row * 1024 + col) = make_float4(y0, y1, y2, y3);
            else { uint2 o; o.x = cvt_pk_bf16(y0, y1); o.y = cvt_pk_bf16(y2, y3); *(uint2*)(XB + (size_t)row * 1024 + col) = o; } }
    }
}

__device__ __forceinline__ float rw_shift(const bf16_t* P1, const float* mu, int tk, int t, int idx) {
    const bf16_t* q = P1 + (size_t)tk * 4352 + 2560 + idx;
    const float u = bf1(q[0]), pv = t > 0 ? bf1(q[-4352]) : 0.f, nx = t < 4095 ? bf1(q[4352]) : 0.f;
    return u + mu[idx] * (pv - u) + mu[1792 + idx] * (nx - u); }

__device__ __forceinline__ void phase_rw_lora(const Params& p, float* lds, int tid, int bid, int nb) {
    const bf16_t* P1 = (const bf16_t*)(p.ws + OFF_P); const float* mu = p.in[21];
    bf16_t* DW0 = (bf16_t*)((unsigned char*)p.out + DO_DW0); bf16_t* DW1 = (bf16_t*)((unsigned char*)p.out + DO_DW1); bf16_t* AA = (bf16_t*)(p.ws + OFF_AA);
    const float* w2 = p.in[23]; const float* a2 = p.in[25];
    float* tw = lds; float* al = lds + 1024;
    for (int it = bid; it < 1024; it += nb) {
#pragma unroll
        for (int k = 0; k < 2; ++k) { const int idx = tid + 512 * k, tt = idx >> 6, c = idx & 63, tk = it * 16 + tt, t = tk & 4095;
            tw[c * 16 + tt] = tanhf(rw_shift(P1, mu, tk, t, 1536 + c)); al[c * 16 + tt] = rw_shift(P1, mu, tk, t, 1600 + c); }
        __syncthreads();
        float a0[16], a1[16], aa[16];
#pragma unroll
        for (int i = 0; i < 16; ++i) { a0[i] = 0.f; a1[i] = 0.f; aa[i] = 0.f; }
#pragma unroll 2
        for (int r = 0; r < 64; ++r) { const float x0 = w2[r * 512 + tid], x1 = w2[32768 + r * 512 + tid], xa = a2[r * 512 + tid];
#pragma unroll
            for (int i4 = 0; i4 < 4; ++i4) { const float4 tv = *(const float4*)(tw + r * 16 + i4 * 4), av = *(const float4*)(al + r * 16 + i4 * 4);
                a0[i4 * 4 + 0] += tv.x * x0; a0[i4 * 4 + 1] += tv.y * x0; a0[i4 * 4 + 2] += tv.z * x0; a0[i4 * 4 + 3] += tv.w * x0;
                a1[i4 * 4 + 0] += tv.x * x1; a1[i4 * 4 + 1] += tv.y * x1; a1[i4 * 4 + 2] += tv.z * x1; a1[i4 * 4 + 3] += tv.w * x1;
                aa[i4 * 4 + 0] += av.x * xa; aa[i4 * 4 + 1] += av.y * xa; aa[i4 * 4 + 2] += av.z * xa; aa[i4 * 4 + 3] += av.w * xa; } }
#pragma unroll
        for (int i = 0; i < 16; ++i) { const size_t o = (size_t)(it * 16 + i) * 512 + tid; DW0[o] = f2bf(a0[i]); DW1[o] = f2bf(a1[i]); AA[o] = f2bf(aa[i]); }
        __syncthreads();
    }
}

#define SCAN_TOK(sg) (b * 4096 + (dir ? 4095 - (sg) : (sg)))
#define SCAN_FLUSH(tile_, bsel_, colbase_) { const int stp = tid >> 4, pr = tid & 15; const int tk = SCAN_TOK((tile_) * 16 + stp); \
        *(unsigned*)(OUT + (size_t)tk * 1024 + (colbase_) + pr * 2) = cvt_pk_bf16(ot[(((bsel_) * 16 + stp) * 32 + pr * 2) * 8], ot[(((bsel_) * 16 + stp) * 32 + pr * 2 + 1) * 8]); }

__device__ __forceinline__ void gdn_scan(const Params& p, int item, float* lds, int tid) {
    const int dir = item >> 6, b = (item >> 4) & 3, h = (item >> 2) & 3, sl = item & 3;
    float* kq = lds; float* vv = lds + 8448; float* sc = vv + 1024; float* ot = sc + 64;
    const bf16_t* QK = (const bf16_t*)(p.ws + OFF_QKVP); const float* SC = (const float*)(p.ws + OFF_SC);
    bf16_t* OUT = dir ? (bf16_t*)((unsigned char*)p.out + DO_OB) : (bf16_t*)(p.ws + OFF_MIX);
    if (tid >= 256) {
        const int lt = tid - 256, st = lt >> 4, pp = lt & 15;
        uint4 aq, ak, av = make_uint4(0, 0, 0, 0), bq = av, bk = av, bv = av; float4 as = make_float4(0.f, 0.f, 0.f, 0.f), bs = as;
#define GL(tile, q_, k_, v_, s_) { const int tk_ = SCAN_TOK((tile) * 16 + st); const bf16_t* row_ = QK + (size_t)tk_ * 1536 + h * 128; \
            q_ = *(const uint4*)(row_ + pp * 8); k_ = *(const uint4*)(row_ + 512 + pp * 8); \
            if (pp < 4) v_ = *(const uint4*)(row_ + 1024 + sl * 32 + pp * 8); \
            if (pp == 4) s_ = *(const float4*)(SC + ((size_t)tk_ * 4 + h) * 4); }
#define GS(buf, q_, k_, v_, s_) { const int el_ = pp * 8, o_ = ((buf) * 16 + st) * 264 + el_ + ((el_ >> 6) << 2); unpack8(k_, kq + o_); unpack8(q_, kq + o_ + 132); \
            if (pp < 4) unpack8(v_, vv + ((buf) * 16 + st) * 32 + pp * 8); \
            if (pp == 4) { sc[((buf) * 16 + st) * 2] = s_.x; sc[((buf) * 16 + st) * 2 + 1] = dir ? s_.z : s_.y; } }
        GL(0, aq, ak, av, as); GS(0, aq, ak, av, as); GL(1, aq, ak, av, as);
        __syncthreads();
        for (int tile = 0; tile < 256; ++tile) {
            if (tile + 2 < 256) GL(tile + 2, bq, bk, bv, bs);
            if (tile + 1 < 256) GS((tile + 1) & 1, aq, ak, av, as);
            aq = bq; ak = bk; av = bv; as = bs;
            __syncthreads();
        }
#undef GL
#undef GS
    } else {
        __builtin_amdgcn_s_setprio(3);
        const int e = tid >> 3, j = tid & 7;
        f32x2_t s2[8];
#pragma unroll
        for (int i = 0; i < 8; ++i) s2[i] = (f32x2_t){0.f, 0.f};
        __syncthreads();
        for (int tile = 0; tile < 256; ++tile) {
            const int buf = tile & 1;
            if (tile > 0) SCAN_FLUSH(tile - 1, buf ^ 1, 512 + h * 128 + sl * 32);
            float oreg[16];
            f32x2_t kb[2][8], qb[2][8]; float vb[2], bb[2], gb[2];
#define GDN_LDSTEP(step_, sl_) { const float* kp = kq + (buf * 16 + (step_)) * 264 + j * 16 + ((j >> 2) << 2); \
                _Pragma("unroll") for (int i = 0; i < 4; ++i) { const float4 kv = *(const float4*)(kp + 4 * i), qv = *(const float4*)(kp + 132 + 4 * i); \
                    kb[sl_][2 * i] = (f32x2_t){kv.x, kv.y}; kb[sl_][2 * i + 1] = (f32x2_t){kv.z, kv.w}; qb[sl_][2 * i] = (f32x2_t){qv.x, qv.y}; qb[sl_][2 * i + 1] = (f32x2_t){qv.z, qv.w}; } \
                vb[sl_] = vv[(buf * 16 + (step_)) * 32 + e]; bb[sl_] = sc[(buf * 16 + (step_)) * 2]; gb[sl_] = sc[(buf * 16 + (step_)) * 2 + 1]; }
            GDN_LDSTEP(0, 0);
#pragma unroll
            for (int step = 0; step < 16; ++step) {
                const int cs = step & 1;
                if (step < 15) GDN_LDSTEP(step + 1, cs ^ 1);
                asm volatile("" ::: "memory");
                const float ve = vb[cs], beta = bb[cs], g = gb[cs];
                f32x2_t a0 = kb[cs][0] * s2[0], a1 = kb[cs][1] * s2[1];
                a0 = fma2(kb[cs][2], s2[2], a0); a1 = fma2(kb[cs][3], s2[3], a1); a0 = fma2(kb[cs][4], s2[4], a0); a1 = fma2(kb[cs][5], s2[5], a1); a0 = fma2(kb[cs][6], s2[6], a0); a1 = fma2(kb[cs][7], s2[7], a1);
                a0 = a0 + a1;
                const float ks = rowsum8(a0.x + a0.y);
                const float tmp = beta * (ve - g * ks);
                const f32x2_t g2 = (f32x2_t){g, g}, t2 = (f32x2_t){tmp, tmp};
#pragma unroll
                for (int i = 0; i < 8; ++i) s2[i] = fma2(s2[i], g2, kb[cs][i] * t2);
                f32x2_t b0 = qb[cs][0] * s2[0], b1 = qb[cs][1] * s2[1];
                b0 = fma2(qb[cs][2], s2[2], b0); b1 = fma2(qb[cs][3], s2[3], b1); b0 = fma2(qb[cs][4], s2[4], b0); b1 = fma2(qb[cs][5], s2[5], b1); b0 = fma2(qb[cs][6], s2[6], b0); b1 = fma2(qb[cs][7], s2[7], b1);
                b0 = b0 + b1;
                oreg[step] = rowsum8(b0.x + b0.y);
            }
#undef GDN_LDSTEP
#pragma unroll
            for (int step = 0; step < 16; ++step) ot[((buf * 16 + step) * 32 + e) * 8 + j] = oreg[step];
            __syncthreads();
        }
        SCAN_FLUSH(255, 1, 512 + h * 128 + sl * 32);
        __builtin_amdgcn_s_setprio(0);
    }
    __syncthreads();
}

__device__ __forceinline__ void hgrn_scan(const Params& p, int item, float* lds, int tid) {
    const int dir = item >> 6, b = (item >> 4) & 3, h = (item >> 2) & 3, sl = item & 3;
    float* kq = lds; float* vv = lds + 8448; float* ot = vv + 1024;
    const bf16_t* P1 = (const bf16_t*)(p.ws + OFF_P);
    bf16_t* OUT = dir ? (bf16_t*)((unsigned char*)p.out + DO_OB) : (bf16_t*)(p.ws + OFF_MIX);
    if (tid >= 256) {
        const int lt = tid - 256, st = lt >> 4, pp = lt & 15;
        float lb[8];
        { const int cb = h * 128 + pp * 8;
#pragma unroll
          for (int i = 0; i < 8; ++i) lb[i] = sigm(p.in[19][512 + cb + i] - p.in[19][cb + i]); }
        uint4 aq, af, av = make_uint4(0, 0, 0, 0), bq = av, bf_ = av, bv = av;
#define HL(tile, q_, f_, v_) { const int tk_ = SCAN_TOK((tile) * 16 + st); const bf16_t* row_ = P1 + (size_t)tk_ * 4352 + h * 128; \
            q_ = *(const uint4*)(row_ + pp * 8); f_ = *(const uint4*)(row_ + 512 + dir * 512 + pp * 8); \
            if (pp < 4) v_ = *(const uint4*)(row_ + 1536 + sl * 32 + pp * 8); }
#define HS(buf, q_, f_, v_) { float t8[8], u8[8]; \
            t8[0] = bflo(q_.x); t8[1] = bfhi(q_.x); t8[2] = bflo(q_.y); t8[3] = bfhi(q_.y); t8[4] = bflo(q_.z); t8[5] = bfhi(q_.z); t8[6] = bflo(q_.w); t8[7] = bfhi(q_.w); \
            u8[0] = bflo(f_.x); u8[1] = bfhi(f_.x); u8[2] = bflo(f_.y); u8[3] = bfhi(f_.y); u8[4] = bflo(f_.z); u8[5] = bfhi(f_.z); u8[6] = bflo(f_.w); u8[7] = bfhi(f_.w); \
            _Pragma("unroll") for (int i = 0; i < 8; ++i) { t8[i] = silu(t8[i]); u8[i] = lb[i] + (1.f - lb[i]) * sigm(u8[i]); } \
            const int el_ = pp * 8; float* d_ = kq + ((buf) * 16 + st) * 264 + el_ + ((el_ >> 6) << 2); \
            *(float4*)d_ = make_float4(u8[0], u8[1], u8[2], u8[3]); *(float4*)(d_ + 4) = make_float4(u8[4], u8[5], u8[6], u8[7]); \
            *(float4*)(d_ + 132) = make_float4(t8[0], t8[1], t8[2], t8[3]); *(float4*)(d_ + 136) = make_float4(t8[4], t8[5], t8[6], t8[7]); \
            if (pp < 4) unpack8(v_, vv + ((buf) * 16 + st) * 32 + pp * 8); }
        uint4 cq = av, cf = av, cv = av;
        HL(0, aq, af, av); HS(0, aq, af, av); HL(1, aq, af, av); HL(2, bq, bf_, bv);
        __syncthreads();
        for (int tile = 0; tile < 256; ++tile) {
            if (tile + 3 < 256) HL(tile + 3, cq, cf, cv);
            if (tile + 1 < 256) HS((tile + 1) & 1, aq, af, av);
            aq = bq; af = bf_; av = bv; bq = cq; bf_ = cf; bv = cv;
            __syncthreads();
        }
#undef HL
#undef HS
    } else {
        __builtin_amdgcn_s_setprio(3);
        const int e = tid >> 3, j = tid & 7;
        f32x2_t s2[8];
#pragma unroll
        for (int i = 0; i < 8; ++i) s2[i] = (f32x2_t){0.f, 0.f};
        __syncthreads();
        for (int tile = 0; tile < 256; ++tile) {
            const int buf = tile & 1;
            if (tile > 0) SCAN_FLUSH(tile - 1, buf ^ 1, h * 128 + sl * 32);
            float oreg[16];
            f32x2_t fb[3][8], qb[3][8]; float vb[3];
#define HG_LDSTEP(step_, sl_) { const float* kp = kq + (buf * 16 + (step_)) * 264 + j * 16 + ((j >> 2) << 2); \
                _Pragma("unroll") for (int i = 0; i < 4; ++i) { const float4 kv = *(const float4*)(kp + 4 * i), qv = *(const float4*)(kp + 132 + 4 * i); \
                    fb[sl_][2 * i] = (f32x2_t){kv.x, kv.y}; fb[sl_][2 * i + 1] = (f32x2_t){kv.z, kv.w}; qb[sl_][2 * i] = (f32x2_t){qv.x, qv.y}; qb[sl_][2 * i + 1] = (f32x2_t){qv.z, qv.w}; } \
                vb[sl_] = vv[(buf * 16 + (step_)) * 32 + e]; }
            HG_LDSTEP(0, 0); HG_LDSTEP(1, 1);
#pragma unroll
            for (int step = 0; step < 16; ++step) {
                const int cs = step % 3;
                if (step < 14) HG_LDSTEP(step + 2, (step + 2) % 3);
                asm volatile("" ::: "memory");
                const f32x2_t v2 = (f32x2_t){vb[cs], vb[cs]};
#pragma unroll
                for (int i = 0; i < 8; ++i) s2[i] = fma2(fb[cs][i], s2[i] - v2, v2);
                f32x2_t b0 = qb[cs][0] * s2[0], b1 = qb[cs][1] * s2[1];
                b0 = fma2(qb[cs][2], s2[2], b0); b1 = fma2(qb[cs][3], s2[3], b1); b0 = fma2(qb[cs][4], s2[4], b0); b1 = fma2(qb[cs][5], s2[5], b1); b0 = fma2(qb[cs][6], s2[6], b0); b1 = fma2(qb[cs][7], s2[7], b1);
                b0 = b0 + b1;
                oreg[step] = rowsum8(b0.x + b0.y);
            }
#undef HG_LDSTEP
#pragma unroll
            for (int step = 0; step < 16; ++step) ot[((buf * 16 + step) * 32 + e) * 8 + j] = oreg[step];
            __syncthreads();
        }
        SCAN_FLUSH(255, 1, h * 128 + sl * 32);
        __builtin_amdgcn_s_setprio(0);
    }
    __syncthreads();
}

__device__ __forceinline__ void rwkv_scan(const Params& p, int item, float* lds, int tid) {
    const int dir = item >> 6, b = (item >> 4) & 3, hh = (item >> 1) & 7, half = item & 1;
    float* tl = lds;
    float* ot = lds + 2 * 16 * 384;
    const bf16_t* P1 = (const bf16_t*)(p.ws + OFF_P);
    bf16_t* OUT = dir ? (bf16_t*)((unsigned char*)p.out + DO_OB) : (bf16_t*)(p.ws + OFF_MIX);
    if (tid >= 256) {
        const bf16_t* DW = (const bf16_t*)((unsigned char*)p.out + (dir ? DO_DW1 : DO_DW0)); const bf16_t* AA = (const bf16_t*)(p.ws + OFF_AA);
        const int lt = tid - 256, st = lt >> 4, cq = lt & 15, ch = hh * 64 + cq * 4;
        const float* mu = p.in[21];
        float m0[3][4], m1[3][4], a0c[4], w0c[4], kkc[4], kac[4];
#pragma unroll
        for (int q = 0; q < 4; ++q) {
#pragma unroll
            for (int s3 = 0; s3 < 3; ++s3) { m0[s3][q] = mu[s3 * 512 + ch + q]; m1[s3][q] = mu[1792 + s3 * 512 + ch + q]; }
            a0c[q] = p.in[24][ch + q]; w0c[q] = p.in[22][dir * 512 + ch + q]; kkc[q] = p.in[27][ch + q]; kac[q] = p.in[28][ch + q]; }
        uint2 au[3][3], bu[3][3], adw, ada, bdw, bda;
#define RL(tile, u_, dw_, da_) { const int tk_ = SCAN_TOK((tile) * 16 + st), t_ = tk_ & 4095; const bf16_t* row_ = P1 + (size_t)tk_ * 4352 + 2560 + ch; \
            const int po_ = t_ > 0 ? -4352 : 0, no_ = t_ < 4095 ? 4352 : 0; \
            _Pragma("unroll") for (int s3 = 0; s3 < 3; ++s3) { u_[1][s3] = *(const uint2*)(row_ + s3 * 512); u_[0][s3] = *(const uint2*)(row_ + po_ + s3 * 512); u_[2][s3] = *(const uint2*)(row_ + no_ + s3 * 512); \
                if (t_ == 0) u_[0][s3] = make_uint2(0u, 0u); if (t_ == 4095) u_[2][s3] = make_uint2(0u, 0u); } \
            dw_ = *(const uint2*)(DW + (size_t)tk_ * 512 + ch); da_ = *(const uint2*)(AA + (size_t)tk_ * 512 + ch); }
#define RS(buf, u_, dw_, da_) { float us[3][4], pv[4], nx[4], cu[4]; \
            _Pragma("unroll") for (int s3 = 0; s3 < 3; ++s3) { \
                cu[0] = bflo(u_[1][s3].x); cu[1] = bfhi(u_[1][s3].x); cu[2] = bflo(u_[1][s3].y); cu[3] = bfhi(u_[1][s3].y); \
                pv[0] = bflo(u_[0][s3].x); pv[1] = bfhi(u_[0][s3].x); pv[2] = bflo(u_[0][s3].y); pv[3] = bfhi(u_[0][s3].y); \
                nx[0] = bflo(u_[2][s3].x); nx[1] = bfhi(u_[2][s3].x); nx[2] = bflo(u_[2][s3].y); nx[3] = bfhi(u_[2][s3].y); \
                _Pragma("unroll") for (int q = 0; q < 4; ++q) us[s3][q] = cu[q] + m0[s3][q] * (pv[q] - cu[q]) + m1[s3][q] * (nx[q] - cu[q]); } \
            float dwv[4], dav[4], av[4], dc[4], kr[4]; \
            dwv[0] = bflo(dw_.x); dwv[1] = bfhi(dw_.x); dwv[2] = bflo(dw_.y); dwv[3] = bfhi(dw_.y); dav[0] = bflo(da_.x); dav[1] = bfhi(da_.x); dav[2] = bflo(da_.y); dav[3] = bfhi(da_.y); \
            float ss = 0.f; \
            _Pragma("unroll") for (int q = 0; q < 4; ++q) { av[q] = sigm(a0c[q] + dav[q]); dc[q] = __expf(-0.6065306597126334f * sigm(w0c[q] + dwv[q])); kr[q] = us[1][q] * kkc[q]; ss += kr[q] * kr[q]; } \
            ss = rowsum16(ss); const float rn = rsqrtf(ss + 1e-6f); \
            float* d_ = tl + ((buf) * 16 + st) * 384 + cq * 4; \
            *(float4*)(d_) = make_float4(us[0][0], us[0][1], us[0][2], us[0][3]); *(float4*)(d_ + 64) = make_float4(dc[0], dc[1], dc[2], dc[3]); \
            *(float4*)(d_ + 128) = make_float4(us[1][0] * (1.f + (av[0] - 1.f) * kac[0]), us[1][1] * (1.f + (av[1] - 1.f) * kac[1]), us[1][2] * (1.f + (av[2] - 1.f) * kac[2]), us[1][3] * (1.f + (av[3] - 1.f) * kac[3])); \
            *(float4*)(d_ + 192) = make_float4(kr[0] * rn, kr[1] * rn, kr[2] * rn, kr[3] * rn); *(float4*)(d_ + 256) = make_float4(kr[0] * rn * av[0], kr[1] * rn * av[1], kr[2] * rn * av[2], kr[3] * rn * av[3]); \
            *(float4*)(d_ + 320) = make_float4(us[2][0], us[2][1], us[2][2], us[2][3]); }
        RL(0, au, adw, ada); RS(0, au, adw, ada); RL(1, au, adw, ada);
        __syncthreads();
        for (int tile = 0; tile < 256; ++tile) {
            if (tile + 2 < 256) RL(tile + 2, bu, bdw, bda);
            if (tile + 1 < 256) RS((tile + 1) & 1, au, adw, ada);
#pragma unroll
            for (int a = 0; a < 3; ++a)
#pragma unroll
                for (int c = 0; c < 3; ++c) au[a][c] = bu[a][c];
            adw = bdw; ada = bda;
            __syncthreads();
        }
#undef RL
#undef RS
    } else {
        __builtin_amdgcn_s_setprio(3);
        const int e = tid >> 3, j = tid & 7, vrow = half * 32 + e;
        f32x2_t s2[4];
#pragma unroll
        for (int i = 0; i < 4; ++i) s2[i] = (f32x2_t){0.f, 0.f};
        __syncthreads();
        for (int tile = 0; tile < 256; ++tile) {
            const int buf = tile & 1;
            if (tile > 0) SCAN_FLUSH(tile - 1, buf ^ 1, 512 + hh * 64 + half * 32);
            float oreg[16];
            f32x2_t rb[3][4], wb[3][4], kb[3][4], kkb[3][4], kab[3][4]; float vb[3];
#define RW_LDSTEP(step_, sl_) { const float* bp = tl + (buf * 16 + (step_)) * 384 + j * 8; \
                _Pragma("unroll") for (int i = 0; i < 2; ++i) { const float4 rv = *(const float4*)(bp + 4 * i), wv = *(const float4*)(bp + 64 + 4 * i), kv = *(const float4*)(bp + 128 + 4 * i), kkv = *(const float4*)(bp + 192 + 4 * i), kav = *(const float4*)(bp + 256 + 4 * i); \
                    rb[sl_][2 * i] = (f32x2_t){rv.x, rv.y}; rb[sl_][2 * i + 1] = (f32x2_t){rv.z, rv.w}; wb[sl_][2 * i] = (f32x2_t){wv.x, wv.y}; wb[sl_][2 * i + 1] = (f32x2_t){wv.z, wv.w}; \
                    kb[sl_][2 * i] = (f32x2_t){kv.x, kv.y}; kb[sl_][2 * i + 1] = (f32x2_t){kv.z, kv.w}; kkb[sl_][2 * i] = (f32x2_t){kkv.x, kkv.y}; kkb[sl_][2 * i + 1] = (f32x2_t){kkv.z, kkv.w}; \
                    kab[sl_][2 * i] = (f32x2_t){kav.x, kav.y}; kab[sl_][2 * i + 1] = (f32x2_t){kav.z, kav.w}; } \
                vb[sl_] = tl[(buf * 16 + (step_)) * 384 + 320 + vrow]; }
            RW_LDSTEP(0, 0); RW_LDSTEP(1, 1);
#pragma unroll
            for (int step = 0; step < 16; ++step) {
                const int cs = step % 3;
                if (step < 14) RW_LDSTEP(step + 2, (step + 2) % 3);
                asm volatile("" ::: "memory");
                f32x2_t a0 = kkb[cs][0] * s2[0], a1 = kkb[cs][1] * s2[1]; a0 = fma2(kkb[cs][2], s2[2], a0); a1 = fma2(kkb[cs][3], s2[3], a1); a0 = a0 + a1;
                const float sa = rowsum8(a0.x + a0.y);
                const f32x2_t nsa = (f32x2_t){-sa, -sa}, v2 = (f32x2_t){vb[cs], vb[cs]};
#pragma unroll
                for (int i = 0; i < 4; ++i) s2[i] = fma2(v2, kb[cs][i], fma2(nsa, kab[cs][i], s2[i] * wb[cs][i]));
                f32x2_t b0 = rb[cs][0] * s2[0], b1 = rb[cs][1] * s2[1]; b0 = fma2(rb[cs][2], s2[2], b0); b1 = fma2(rb[cs][3], s2[3], b1); b0 = b0 + b1;
                oreg[step] = rowsum8(b0.x + b0.y);
            }
#undef RW_LDSTEP
#pragma unroll
            for (int step = 0; step < 16; ++step) ot[((buf * 16 + step) * 32 + e) * 8 + j] = oreg[step];
            __syncthreads();
        }
        SCAN_FLUSH(255, 1, 512 + hh * 64 + half * 32);
        __builtin_amdgcn_s_setprio(0);
    }
    __syncthreads();
}
#undef SCAN_TOK
#undef SCAN_FLUSH

__device__ __forceinline__ void phase_post1(const Params& p, float* lds, int tid, int bid, int nb) {
    const int wave = tid >> 6, lane = tid & 63;
    bf16_t* MIX = (bf16_t*)(p.ws + OFF_MIX); const bf16_t* OB = (const bf16_t*)((unsigned char*)p.out + DO_OB); const bf16_t* P1 = (const bf16_t*)(p.ws + OFF_P);
    { const float* nw = p.in[20]; float nw8[8];
#pragma unroll
      for (int i = 0; i < 8; ++i) nw8[i] = nw[(lane & 15) * 8 + i];
#pragma unroll 2
      for (int tk = bid * 8 + wave; tk < 16384; tk += nb * 8) { const size_t o = (size_t)tk * 1024 + lane * 8;
          gate_norm_token(MIX + o, OB + o, P1 + (size_t)tk * 4352 + 2048 + lane * 8, nw8); } }
    { const float* mu = p.in[21]; const float* g2 = p.in[26]; const bf16_t* AA = (const bf16_t*)(p.ws + OFF_AA);
      float* sg = lds; float* gl = lds + 2048;
      const int cb = lane * 8;
      float m0[3][8], m1[3][8], a0v[8], kav[8], rkv[8], lwv[8], lbv[8];
#pragma unroll
      for (int i = 0; i < 8; ++i) {
#pragma unroll
          for (int s3 = 0; s3 < 3; ++s3) { m0[s3][i] = mu[s3 * 512 + cb + i]; m1[s3][i] = mu[1792 + s3 * 512 + cb + i]; }
          a0v[i] = p.in[24][cb + i]; kav[i] = p.in[28][cb + i]; rkv[i] = p.in[29][cb + i]; lwv[i] = p.in[30][cb + i]; lbv[i] = p.in[31][cb + i]; }
      for (int it = bid; it < 1024; it += nb) {
#pragma unroll
          for (int k = 0; k < 4; ++k) { const int idx = tid + 512 * k, tt = idx >> 7, r = idx & 127, tk = it * 16 + tt; sg[r * 16 + tt] = sigm(rw_shift(P1, mu, tk, tk & 4095, 1664 + r)); }
          __syncthreads();
          { float acc[16];
#pragma unroll
            for (int i = 0; i < 16; ++i) acc[i] = 0.f;
#pragma unroll 4
            for (int r = 0; r < 128; ++r) { const float gv = g2[r * 512 + tid];
#pragma unroll
                for (int i4 = 0; i4 < 4; ++i4) { const float4 sv = *(const float4*)(sg + r * 16 + i4 * 4);
                    acc[i4 * 4 + 0] += sv.x * gv; acc[i4 * 4 + 1] += sv.y * gv; acc[i4 * 4 + 2] += sv.z * gv; acc[i4 * 4 + 3] += sv.w * gv; } }
#pragma unroll
            for (int i = 0; i < 16; ++i) gl[i * 512 + tid] = acc[i]; }
          __syncthreads();
#pragma unroll 1
          for (int ps = 0; ps < 2; ++ps) { const int tt = wave + 8 * ps, tk = it * 16 + tt, t = tk & 4095;
              const bf16_t* row = P1 + (size_t)tk * 4352 + 2560 + cb; const bool hp = t > 0, hn = t < 4095; const int po = hp ? -4352 : 0, no = hn ? 4352 : 0;
              float us[3][8];
#pragma unroll
              for (int s3 = 0; s3 < 3; ++s3) { const uint4 c4 = *(const uint4*)(row + s3 * 512), p4 = *(const uint4*)(row + po + s3 * 512), n4 = *(const uint4*)(row + no + s3 * 512);
                  const unsigned cw[4] = {c4.x, c4.y, c4.z, c4.w}, pw[4] = {p4.x, p4.y, p4.z, p4.w}, nw_[4] = {n4.x, n4.y, n4.z, n4.w};
#pragma unroll
                  for (int q = 0; q < 4; ++q) { const float c0 = bflo(cw[q]), c1 = bfhi(cw[q]);
                      const float p0 = hp ? bflo(pw[q]) : 0.f, p1 = hp ? bfhi(pw[q]) : 0.f, n0_ = hn ? bflo(nw_[q]) : 0.f, n1_ = hn ? bfhi(nw_[q]) : 0.f;
                      us[s3][2 * q] = c0 + m0[s3][2 * q] * (p0 - c0) + m1[s3][2 * q] * (n0_ - c0);
                      us[s3][2 * q + 1] = c1 + m0[s3][2 * q + 1] * (p1 - c1) + m1[s3][2 * q + 1] * (n1_ - c1); } }
              const uint4 a4 = *(const uint4*)(AA + (size_t)tk * 512 + cb); const unsigned aw[4] = {a4.x, a4.y, a4.z, a4.w};
              const size_t o = (size_t)tk * 1024 + 512 + cb;
              const uint4 f4 = *(const uint4*)(MIX + o), b4 = *(const uint4*)(OB + o); const unsigned fw[4] = {f4.x, f4.y, f4.z, f4.w}, bw[4] = {b4.x, b4.y, b4.z, b4.w};
              float y[8]; float d0 = 0.f, d1 = 0.f;
#pragma unroll
              for (int q = 0; q < 4; ++q) {
                  const float av0 = sigm(a0v[2 * q] + bflo(aw[q])), av1 = sigm(a0v[2 * q + 1] + bfhi(aw[q]));
                  const float kp0 = us[1][2 * q] * (1.f + (av0 - 1.f) * kav[2 * q]), kp1 = us[1][2 * q + 1] * (1.f + (av1 - 1.f) * kav[2 * q + 1]);
                  d0 += us[0][2 * q] * kp0 * rkv[2 * q] + us[0][2 * q + 1] * kp1 * rkv[2 * q + 1];
                  y[2 * q] = bflo(fw[q]) + bflo(bw[q]); y[2 * q + 1] = bfhi(fw[q]) + bfhi(bw[q]); d1 += y[2 * q] + y[2 * q + 1]; }
              d0 = rowsum8(d0); d1 = rowsum8(d1);
              const float mean = d1 * (1.f / 64.f); float vs_ = 0.f;
#pragma unroll
              for (int i = 0; i < 8; ++i) { y[i] -= mean; vs_ += y[i] * y[i]; }
              const float rstd = rsqrtf(rowsum8(vs_) * (1.f / 64.f) + 64e-5f);
              const float4 g0 = *(const float4*)(gl + tt * 512 + cb), g1 = *(const float4*)(gl + tt * 512 + cb + 4); const float gg[8] = {g0.x, g0.y, g0.z, g0.w, g1.x, g1.y, g1.z, g1.w};
              float ov[8];
#pragma unroll
              for (int i = 0; i < 8; ++i) ov[i] = (y[i] * rstd * lwv[i] + lbv[i] + d0 * us[2][i]) * gg[i];
              uint4 w; w.x = cvt_pk_bf16(ov[0], ov[1]); w.y = cvt_pk_bf16(ov[2], ov[3]); w.z = cvt_pk_bf16(ov[4], ov[5]); w.w = cvt_pk_bf16(ov[6], ov[7]);
              *(uint4*)(MIX + o) = w; }
          __syncthreads();
      } }
}


__global__ void __launch_bounds__(512, 2) hybrid_fwd(Params p) {
    extern __shared__ __attribute__((aligned(16))) unsigned char shm[];
    cg::grid_group grid = cg::this_grid();
    const int tid = threadIdx.x, bid = blockIdx.x, nb = gridDim.x;
    float* lds = (float*)shm; unsigned char* ws = p.ws;
    bf16_t* XB = (bf16_t*)(ws + OFF_XB); bf16_t* MIX = (bf16_t*)(ws + OFF_MIX); bf16_t* Pb = (bf16_t*)(ws + OFF_P); float* TMPP = (float*)(ws + OFF_P);
    const float* lng = p.in[33]; const float* lnb = p.in[34];

    volatile LAS unsigned* xst = (volatile LAS unsigned*)(shm + 131072 + 1024);
    if (tid < 4) xst[tid] = 0u;
    __syncthreads();
    const XcdBarrier xb = xcd_barrier_post((unsigned*)(ws + OFF_BAR), xst);
    phase_prep(p, lds, tid, bid, nb);
    xcd_barrier(xb);
    { EpiBf<0> e1; e1.O = (bf16_t*)(ws + OFF_PH); e1.ldc = 16384; run_gemm(shm, (const bf16_t*)(ws + OFF_EV_IN), XB, 1536, 16384, 1024, e1, bid);
      EpiBf<0> e2; e2.O = (bf16_t*)(ws + OFF_PG); e2.ldc = 2304; run_gemm(shm, XB, (const bf16_t*)(ws + OFF_EV_IN) + (size_t)1536 * 1024, 16384, 2304, 1024, e2, (bid + (nb >> 1)) % nb); }
    xcd_barrier(xb);
    phase_gdn_prep(p, tid, bid, nb);
    xcd_barrier(xb);
    if (bid < 128) gdn_scan(p, bid, lds, tid);
    else { for (int c = bid - 128; c < 512; c += nb - 128) hyena_channel(p, c, bid - 128, lds, tid);
           prep_weights_a(p, lds, tid, bid - 128, nb - 128); }
    grid.sync();
    phase_post0(p, lds, tid, bid, nb);
    xcd_barrier(xb);
    { EpiRes<false> e; e.C = TMPP; e.res = p.in[0]; run_gemm(shm, MIX, (const bf16_t*)(ws + OFF_EV_OUT), 16384, 1024, 1024, e, bid); }
    xcd_barrier(xb);
    phase_ln<false>(TMPP, lng, lnb, XB, nullptr, tid, bid, nb);
    xcd_barrier(xb);
    { EpiBf<1> e; e.O = Pb; e.ldc = 4096; run_gemm(shm, XB, (const bf16_t*)(ws + OFF_W1_0), 16384, 4096, 1024, e, bid); }
    xcd_barrier(xb);
    { EpiRes<true> e; e.C = p.out; e.res = XB; run_gemm(shm, Pb, (const bf16_t*)(ws + OFF_W2_0), 16384, 1024, 4096, e, bid); }
    xcd_barrier(xb);
    phase_ln<false>(p.out, lng + 1024, lnb + 1024, XB, nullptr, tid, bid, nb);
    xcd_barrier(xb);
    { EpiBf<0> e; e.O = Pb; e.ldc = 4352; run_gemm(shm, XB, (const bf16_t*)(ws + OFF_OD_IN), 16384, 4352, 1024, e, bid); }
    xcd_barrier(xb);
    phase_rw_lora(p, lds, tid, bid, nb);
    xcd_barrier(xb);
    if (bid < 128) { hgrn_scan(p, bid, lds, tid); prep_weights_b(p, lds, tid, bid, 128); }
    else for (int it = bid - 128; it < 128; it += nb - 128) rwkv_scan(p, it, lds, tid);
    xcd_barrier(xb);
    phase_post1(p, lds, tid, bid, nb);
    xcd_barrier(xb);
    { EpiRes<true> e; e.C = TMPP; e.res = XB; run_gemm(shm, MIX, (const bf16_t*)(ws + OFF_OD_OUT), 16384, 1024, 1024, e, bid); }
    xcd_barrier(xb);
    phase_ln<false>(TMPP, lng + 2048, lnb + 2048, XB, nullptr, tid, bid, nb);
    xcd_barrier(xb);
    { EpiBf<1> e; e.O = Pb; e.ldc = 4096; run_gemm(shm, XB, (const bf16_t*)(ws + OFF_W1_1), 16384, 4096, 1024, e, bid); }
    xcd_barrier(xb);
    { EpiRes<true> e; e.C = p.out; e.res = XB; run_gemm(shm, Pb, (const bf16_t*)(ws + OFF_W2_1), 16384, 1024, 4096, e, bid); }
    xcd_barrier(xb);
    phase_ln<true>(p.out, lng + 3072, lnb + 3072, nullptr, p.out, tid, bid, nb);
}

extern "C" void kernel_launch(void* const* d_in, const int* in_sizes, int n_in, void* d_out, int out_size, void* d_ws, size_t ws_size, hipStream_t stream) {
    static int grid_blocks = 0;
    if (!grid_blocks) {
        int dev = 0, cus = 0, per_cu = 0;
        hipGetDevice(&dev);
        hipDeviceGetAttribute(&cus, hipDeviceAttributeMultiprocessorCount, dev);
        hipFuncSetAttribute((const void*)hybrid_fwd, hipFuncAttributeMaxDynamicSharedMemorySize, LDS_BYTES);
        hipOccupancyMaxActiveBlocksPerMultiprocessor(&per_cu, (const void*)hybrid_fwd, 512, LDS_BYTES);
        if (per_cu < 1) { fprintf(stderr, "kernel_launch: occupancy query says %d blocks per CU\n", per_cu); per_cu = 1; }
        grid_blocks = cus * per_cu;
        if (n_in != 37 || ws_size < 254 * MBy) fprintf(stderr, "kernel_launch: unexpected n_in %d / ws_size %zu\n", n_in, ws_size);
    }
    hipMemsetAsync((unsigned char*)d_ws + OFF_BAR, 0, XCD_BAR_WORDS * sizeof(unsigned), stream);
    Params p{};
    for (int i = 0; i < 37; ++i) p.in[i] = (const float*)d_in[i];
    p.out = (float*)d_out; p.ws = (unsigned char*)d_ws;
    void* args[] = {&p};
    hipError_t e = hipLaunchCooperativeKernel((const void*)hybrid_fwd, dim3(grid_blocks), dim3(512), args, LDS_BYTES, stream);
    if (e != hipSuccess) fprintf(stderr, "cooperative launch failed: %s (grid %d)\n", hipGetErrorString(e), grid_blocks);
}
```
